# Optimizing an MI355X kernel written in HIP

```python
import jax, jax.numpy as jnp
from jax import lax
import numpy as np

D_MODEL = 1024
BATCH = 8
SEQ = 2048
DEPTH = 2

GRID_W = 64
N_MIXERS = 2
HEAD_DIM = 64
NA_HEADS = 16
NA_WIN_H = 8
NA_WIN_W = 16
NA_QCOL_BLOCK = 16
NA_KCOL_SPAN = NA_QCOL_BLOCK + NA_WIN_W
SW_Q_HEADS = 16
SW_KV_HEADS = 4
SW_GROUP = SW_Q_HEADS // SW_KV_HEADS
SW_WINDOW = 128
SW_BLOCK = 128
T5_BUCKETS = 32
T5_MAX_DIST = 128
N_EXPERTS = 16
EXPERT_FF = 2048
EC_CAPACITY = 2
RMS_EPS = 1e-6
NEG = -1e30

kernel_name = "hybrid_natten_swa_ec_moe_encoder"


def rms_norm(x, g):
    x32 = x.astype(jnp.float32)
    y = x32 * lax.rsqrt(jnp.mean(x32 * x32, axis=-1, keepdims=True) + RMS_EPS)
    return (y * g.astype(jnp.float32)).astype(x.dtype)


def neighbourhood_attention(h, w_qkv, w_o, rpb):
    B, S, _ = h.shape
    rows = S // GRID_W
    kh = min(NA_WIN_H, rows)
    ncb = GRID_W // NA_QCOL_BLOCK
    q, k, v = jnp.split(h @ w_qkv, 3, axis=-1)
    grid = lambda t: t.reshape(B, rows, GRID_W, NA_HEADS, HEAD_DIM)
    q, k, v = grid(q) * (HEAD_DIM ** -0.5), grid(k), grid(v)
    qcol = np.arange(GRID_W).reshape(ncb, NA_QCOL_BLOCK)
    cstart = np.clip(qcol - NA_WIN_W // 2, 0, GRID_W - NA_WIN_W)
    kstart = np.clip(np.arange(ncb) * NA_QCOL_BLOCK - NA_WIN_W // 2, 0, GRID_W - NA_KCOL_SPAN)
    kcol = kstart[:, None] + np.arange(NA_KCOL_SPAN)
    col_ok = (kcol[:, None, :] >= cstart[:, :, None]) & (kcol[:, None, :] < cstart[:, :, None] + NA_WIN_W)
    dc_idx = np.clip(kcol[:, None, :] - qcol[:, :, None] + NA_WIN_W - 1, 0, 2 * NA_WIN_W - 2)
    mask = col_ok[:, :, None, :]

    def row_step(r):
        rs = jnp.clip(r - kh // 2, 0, rows - kh)
        q_b = lax.dynamic_index_in_dim(q, r, axis=1, keepdims=False).reshape(
            B, ncb, NA_QCOL_BLOCK, NA_HEADS, HEAD_DIM)
        k_b = lax.dynamic_slice_in_dim(k, rs, kh, axis=1)[:, :, kcol]
        v_b = lax.dynamic_slice_in_dim(v, rs, kh, axis=1)[:, :, kcol]
        s = jnp.einsum('bnqhd,binchd->bhnqic', q_b, k_b).astype(jnp.float32)
        dr_idx = rs + jnp.arange(kh) - r + NA_WIN_H - 1
        bias = rpb[:, dr_idx][:, :, dc_idx].astype(jnp.float32)
        bias = jnp.transpose(bias, (0, 2, 3, 1, 4))
        s = jnp.where(mask, s + bias[None], NEG)
        p = jax.nn.softmax(s.reshape(s.shape[:4] + (-1,)), axis=-1).reshape(s.shape)
        o = jnp.einsum('bhnqic,binchd->bnqhd', p.astype(v.dtype), v_b)
        return o.reshape(B, GRID_W, NA_HEADS * HEAD_DIM)

    out = lax.map(row_step, jnp.arange(rows))
    return jnp.moveaxis(out, 0, 1).reshape(B, S, NA_HEADS * HEAD_DIM) @ w_o


def t5_buckets(rel):
    half = T5_BUCKETS // 2
    max_exact = half // 2
    n = np.abs(rel)
    large = max_exact + (np.log(np.maximum(n, 1) / max_exact)
                         / np.log(T5_MAX_DIST / max_exact) * (half - max_exact)).astype(np.int32)
    large = np.minimum(large, half - 1)
    return (rel > 0).astype(np.int32) * half + np.where(n < max_exact, n, large)


def sliding_window_gqa(h, w_qkv, w_o, sinks, t5_table):
    B, S, _ = h.shape
    nb = S // SW_BLOCK
    qkv = h @ w_qkv
    nq = SW_Q_HEADS * HEAD_DIM
    nkv = SW_KV_HEADS * HEAD_DIM
    q = qkv[..., :nq].reshape(B, nb, SW_BLOCK, SW_KV_HEADS, SW_GROUP, HEAD_DIM) * (HEAD_DIM ** -0.5)
    k = qkv[..., nq:nq + nkv].reshape(B, S, SW_KV_HEADS, HEAD_DIM)
    v = qkv[..., nq + nkv:].reshape(B, S, SW_KV_HEADS, HEAD_DIM)

    def band(t):
        tp = jnp.pad(t, ((0, 0), (SW_BLOCK, SW_BLOCK), (0, 0), (0, 0))).reshape(
            B, nb + 2, SW_BLOCK, SW_KV_HEADS, HEAD_DIM)
        return jnp.concatenate([tp[:, :-2], tp[:, 1:-1], tp[:, 2:]], axis=2)

    kb, vb = band(k), band(v)
    rel = (np.arange(3 * SW_BLOCK)[None, :] - SW_BLOCK) - np.arange(SW_BLOCK)[:, None]
    kpos = np.arange(nb)[:, None] * SW_BLOCK - SW_BLOCK + np.arange(3 * SW_BLOCK)[None, :]
    mask = (np.abs(rel) <= SW_WINDOW)[None] & ((kpos >= 0) & (kpos < S))[:, None, :]
    bias = jnp.transpose(t5_table[t5_buckets(rel)].astype(jnp.float32), (2, 0, 1))
    bias = bias.reshape(SW_KV_HEADS, SW_GROUP, 1, SW_BLOCK, 3 * SW_BLOCK)
    s = jnp.einsum('bnqkgd,bnjkd->bkgnqj', q, kb).astype(jnp.float32)
    s = jnp.where(mask, s + bias, NEG)
    sink = sinks.astype(jnp.float32).reshape(1, SW_KV_HEADS, SW_GROUP, 1, 1, 1)
    m = jnp.maximum(jnp.max(s, axis=-1, keepdims=True), sink)
    p = jnp.exp(s - m)
    p = p / (jnp.sum(p, axis=-1, keepdims=True) + jnp.exp(sink - m))
    o = jnp.einsum('bkgnqj,bnjkd->bnqkgd', p.astype(v.dtype), vb)
    return o.reshape(B, S, nq) @ w_o


def expert_choice_ffn(h, w_router, w_gate, w_up, w_down):
    B, S, D = h.shape
    cap = EC_CAPACITY * S // N_EXPERTS
    aff = jax.nn.softmax((h @ w_router).astype(jnp.float32), axis=-1)
    g, idx = lax.top_k(jnp.swapaxes(aff, 1, 2), cap)
    xg = jax.vmap(lambda hb, ib: hb[ib])(h, idx)
    a = jnp.einsum('becd,edf->becf', xg, w_gate)
    u = jnp.einsum('becd,edf->becf', xg, w_up)
    y = jnp.einsum('becf,efd->becd', jax.nn.silu(a) * u, w_down) * g[..., None].astype(h.dtype)
    return jax.vmap(lambda yb, ib: jnp.zeros((S, D), h.dtype).at[ib.reshape(-1)].add(
        yb.reshape(-1, D)))(y, idx)


def setup_inputs(seed: int = 0) -> dict:
    key = jax.random.key(seed)
    ks = jax.random.split(key, 17)
    D = D_MODEL
    n_a = (DEPTH + N_MIXERS - 1) // N_MIXERS
    n_b = DEPTH // N_MIXERS
    nrm = lambda k, shape, s: jax.random.normal(k, shape, jnp.float32) * s
    sw_width = (SW_Q_HEADS + 2 * SW_KV_HEADS) * HEAD_DIM
    return {
        "x": nrm(ks[0], (BATCH, SEQ, D), 1.0),
        "c": nrm(ks[1], (BATCH, D), 1.0),
        "ada_w": nrm(ks[2], (DEPTH, D, 6 * D), 0.5 * D ** -0.5),
        "ada_b": nrm(ks[3], (DEPTH, 6 * D), 0.01),
        "norm_g": 1.0 + nrm(ks[4], (DEPTH, 2, D), 0.01),
        "na_w_qkv": nrm(ks[5], (n_a, D, 3 * NA_HEADS * HEAD_DIM), D ** -0.5),
        "na_w_o": nrm(ks[6], (n_a, NA_HEADS * HEAD_DIM, D), (NA_HEADS * HEAD_DIM) ** -0.5),
        "na_rpb": nrm(ks[7], (n_a, NA_HEADS, 2 * NA_WIN_H - 1, 2 * NA_WIN_W - 1), 0.1),
        "sw_w_qkv": nrm(ks[8], (n_b, D, sw_width), D ** -0.5),
        "sw_w_o": nrm(ks[9], (n_b, SW_Q_HEADS * HEAD_DIM, D), (SW_Q_HEADS * HEAD_DIM) ** -0.5),
        "sw_sinks": nrm(ks[10], (n_b, SW_Q_HEADS), 0.5),
        "t5_bias": nrm(ks[11], (T5_BUCKETS, SW_Q_HEADS), 0.1),
        "moe_w_router": nrm(ks[12], (DEPTH, D, N_EXPERTS), D ** -0.5),
        "moe_w_gate": nrm(ks[13], (DEPTH, N_EXPERTS, D, EXPERT_FF), D ** -0.5),
        "moe_w_up": nrm(ks[14], (DEPTH, N_EXPERTS, D, EXPERT_FF), D ** -0.5),
        "moe_w_down": nrm(ks[15], (DEPTH, N_EXPERTS, EXPERT_FF, D), EXPERT_FF ** -0.5),
        "final_g": 1.0 + nrm(ks[16], (D,), 0.01),
    }


def reference(x, c, ada_w, ada_b, norm_g, na_w_qkv, na_w_o, na_rpb, sw_w_qkv, sw_w_o,
              sw_sinks, t5_bias, moe_w_router, moe_w_gate, moe_w_up, moe_w_down, final_g):
    c_act = jax.nn.silu(c)
    for l in range(DEPTH):
        mod = c_act @ ada_w[l] + ada_b[l]
        sh1, sc1, g1, sh2, sc2, g2 = jnp.split(mod, 6, axis=-1)
        h = rms_norm(x, norm_g[l, 0]) * (1.0 + sc1[:, None]) + sh1[:, None]
        j = l // N_MIXERS
        if l % N_MIXERS == 0:
            y = neighbourhood_attention(h, na_w_qkv[j], na_w_o[j], na_rpb[j])
        else:
            y = sliding_window_gqa(h, sw_w_qkv[j], sw_w_o[j], sw_sinks[j], t5_bias)
        x = x + g1[:, None] * y
        h = rms_norm(x, norm_g[l, 1]) * (1.0 + sc2[:, None]) + sh2[:, None]
        x = x + g2[:, None] * expert_choice_ffn(h, moe_w_router[l], moe_w_gate[l],
                                                moe_w_up[l], moe_w_down[l])
    return rms_norm(x, final_g)
```

```cpp
#include <hip/hip_runtime.h>
#include <cstdio>
#include <cstdint>

#define LAS __attribute__((address_space(3)))
#define GAS __attribute__((address_space(1)))
typedef unsigned short bf16_t;
typedef short bf16x8 __attribute__((ext_vector_type(8)));
typedef short bf16x4 __attribute__((ext_vector_type(4)));
typedef float f32x4 __attribute__((ext_vector_type(4)));
typedef float f32x2 __attribute__((ext_vector_type(2)));
typedef unsigned u32x4 __attribute__((ext_vector_type(4)));
typedef unsigned u32x2 __attribute__((ext_vector_type(2)));
typedef int v4i_t __attribute__((ext_vector_type(4)));

constexpr int BATCH = 8, SEQ = 2048, D = 1024, T = BATCH * SEQ;
constexpr int NE = 16, FF = 2048, CAP = 256, NBE = BATCH * NE;
constexpr float RMS_EPS = 1e-6f;
constexpr float LOG2E = 1.4426950408889634f;

constexpr size_t MiB = 1u << 20;
constexpr size_t WS_CTL = 0, CTL_ZERO_BYTES = 32768;
constexpr size_t WS_MOD = 2 * MiB;
constexpr size_t WS_WQK0 = 4 * MiB;
constexpr size_t WS_WO0 = 10 * MiB;
constexpr size_t WS_WQK1 = 12 * MiB;
constexpr size_t WS_WO1 = 16 * MiB;
constexpr size_t WS_AFF = 18 * MiB;
constexpr size_t WS_SLOT = 19 * MiB;
constexpr size_t WS_IDX = 20 * MiB;
constexpr size_t WS_GSEL = 20 * MiB + 256 * 1024;
constexpr size_t WS_WGU = 32 * MiB;
constexpr size_t WS_WD = 288 * MiB;
constexpr size_t WS_XA = 416 * MiB;
constexpr size_t WS_H = 480 * MiB;
constexpr size_t WS_BIG = 512 * MiB;
constexpr size_t WS_QK = WS_BIG, WS_VT = WS_BIG + 64 * MiB, WS_O = WS_BIG + 96 * MiB, WS_ACT = WS_BIG;
constexpr size_t WS_Y = 640 * MiB;
constexpr size_t WS_END = 704 * MiB;
constexpr int CW_BAR = 4096;

constexpr int RING_BYTES = 131072;
constexpr int TAB_OFF = RING_BYTES;
constexpr int LDSCTL_OFF = TAB_OFF + 8192, MISC_OFF = LDSCTL_OFF + 320;
constexpr int LDS_BYTES = 147456;
static_assert(MISC_OFF + 128 <= LDS_BYTES, "LDS map");

__device__ __forceinline__ unsigned cvt_pk_bf16(float lo, float hi) { unsigned r; asm volatile("v_cvt_pk_bf16_f32 %0, %1, %2" : "=v"(r) : "v"(lo), "v"(hi)); return r; }
__device__ __forceinline__ int opaque(int v) { asm volatile("" : "+v"(v)); return v; }
__device__ __forceinline__ int opaque_s(int v) { asm volatile("" : "+s"(v)); return v; }
__device__ __forceinline__ float bf_lo(unsigned w) { return __uint_as_float(w << 16); }
__device__ __forceinline__ float bf_hi(unsigned w) { return __uint_as_float(w & 0xffff0000u); }
__device__ __forceinline__ float wave_sum(float v) {
#pragma unroll
    for (int o = 1; o < 64; o <<= 1) v += __shfl_xor(v, o);
    return v;
}

namespace pg8 {
constexpr int BM = 256, BK = 64, HALF = 128, HTB = HALF * BK * 2, STAGE_BYTES = 8 * HTB, NXCD = 8, WGM = 8;
__host__ __device__ __forceinline__ int lds_byte(int r, int c) { const int st = (r >> 4) * 2 + (c >> 5), rr = r & 15, cc = c & 31, ob = rr * 64 + cc * 2; return st * 1024 + (ob ^ (((ob >> 9) & 1) << 5)); }
__host__ __device__ __forceinline__ void stage_rc(int b, int& R, int& C) { const int st = b / 1024, sb = b % 1024, swz = sb ^ (((sb >> 9) & 1) << 5); R = (st >> 1) * 16 + swz / 64; C = (st & 1) * 32 + (swz % 64) / 2; }
__host__ __device__ __forceinline__ int perm32(int rho) { const int n = rho >> 4, i = rho & 15; return 8 * (i >> 2) + 4 * n + (i & 3); }

struct Unit { int pm, pn; };

struct StaticOrder {
    int nM, nN, nwg, G, c, K;
    __device__ void init(int M, int N, int K_, int G_, int c_) { nM = M / BM; nN = N / BM; nwg = nM * nN; G = G_; c = c_; K = K_; }
    __device__ bool next(int i, Unit& u) const {
        const long L = (long)i * G + c; if (L >= nwg) return false;
        int wgid = (int)L; { const int q = nwg / NXCD, r = nwg % NXCD, xcd = wgid % NXCD, off = wgid / NXCD; wgid = (xcd < r ? xcd * (q + 1) : r * (q + 1) + (xcd - r) * q) + off; }
        const int nig = WGM * nN, gid = wgid / nig, fm = gid * WGM, gsz = (nM - fm) < WGM ? (nM - fm) : WGM;
        u.pm = fm + ((wgid % nig) % gsz); u.pn = (wgid % nig) / gsz; return true;
    }
    __device__ __forceinline__ unsigned row_off(int, const Unit& u, int rr) const { return (unsigned)((u.pm * BM + rr) * K) * 2u; }
};
struct GUSched {
    int G, c; const LAS unsigned* tab;
    __device__ bool next(int i, Unit& u) const {
        const int L = i * G + c; if (L >= 2048 || i >= 8) return false;
        const int round = L >> 8, w = L & 255, xcd = w & 7, j = w >> 3, nt = 2 * xcd + (j & 1), b = (j >> 1) & 7, e = 2 * round + (j >> 4);
        u.pm = b * 16 + e; u.pn = e * 16 + nt; return true;
    }
    __device__ __forceinline__ unsigned row_off(int ui, const Unit&, int rr) const { return tab[ui * 256 + rr]; }
};
struct DownSched {
    int G, c;
    __device__ bool next(int i, Unit& u) const {
        const int L = i * G + c; if (L >= 512) return false;
        const int round = L >> 8, w = L & 255, xcd = w & 7, j = w >> 3, e = 8 * round + xcd, b = j >> 2, nt = j & 3;
        u.pm = b * 16 + e; u.pn = e * 4 + nt; return true;
    }
    __device__ __forceinline__ unsigned row_off(int, const Unit& u, int rr) const { return (unsigned)((u.pm * BM + rr) * FF); }
};

struct EpiBf16 {
    static constexpr bool PERM = true;
    bf16_t* O; int ldc;
    __device__ __forceinline__ void operator()(const f32x4 (&acc)[2][2][4][2], const Unit& u, int wr, int wc, int fr, int fq) const {
        const int row0 = u.pm * BM + wr * 64 + fr; const int col0 = u.pn * BM + wc * 32 + 8 * fq;
#pragma unroll
        for (int ai = 0; ai < 2; ++ai)
#pragma unroll
            for (int m = 0; m < 4; ++m) { bf16_t* rowp = O + (size_t)(row0 + ai * HALF + m * 16) * ldc + col0;
#pragma unroll
                for (int bj = 0; bj < 2; ++bj) { const f32x4 v0 = acc[ai][bj][m][0], v1 = acc[ai][bj][m][1];
                    u32x4 w; w.x = cvt_pk_bf16(v0[0], v0[1]); w.y = cvt_pk_bf16(v0[2], v0[3]); w.z = cvt_pk_bf16(v1[0], v1[1]); w.w = cvt_pk_bf16(v1[2], v1[3]);
                    *(u32x4*)(rowp + bj * HALF) = w; } }
    }
};
struct EpiRes {
    static constexpr bool PERM = false;
    const float* base; float* out; const float* gate;
    __device__ __forceinline__ void operator()(const f32x4 (&acc)[2][2][4][2], const Unit& u, int wr, int wc, int fr, int fq) const {
        const int col0 = u.pn * BM + wc * 32 + 4 * fq; const int b = u.pm >> 3;
        f32x4 gv[2][2];
#pragma unroll
        for (int bj = 0; bj < 2; ++bj)
#pragma unroll
            for (int n = 0; n < 2; ++n) gv[bj][n] = *(const f32x4*)(gate + (size_t)b * 6144 + col0 + bj * HALF + n * 16);
#pragma unroll
        for (int ai = 0; ai < 2; ++ai)
#pragma unroll
            for (int m = 0; m < 4; ++m) { const size_t off = (size_t)(u.pm * BM + ai * HALF + wr * 64 + m * 16 + fr) * D + col0;
#pragma unroll
                for (int bj = 0; bj < 2; ++bj)
#pragma unroll
                    for (int n = 0; n < 2; ++n) { const f32x4 bs = *(const f32x4*)(base + off + bj * HALF + n * 16);
                        *(f32x4*)(out + off + bj * HALF + n * 16) = bs + gv[bj][n] * acc[ai][bj][m][n]; }
                if (m & 1) asm volatile("" ::: "memory"); }
    }
};
__device__ __forceinline__ float silu_mul(float g, float u) { return g * u * __builtin_amdgcn_rcpf(1.0f + __builtin_amdgcn_exp2f(-g * LOG2E)); }
__device__ __forceinline__ unsigned pk4_fp8(float a, float b, float c, float d) { unsigned w = 0u; w = __builtin_amdgcn_cvt_pk_fp8_f32(a, b, w, false); w = __builtin_amdgcn_cvt_pk_fp8_f32(c, d, w, true); return w; }
struct EpiGLU {
    static constexpr bool PERM = true;
    unsigned char* O;
    __device__ __forceinline__ void operator()(const f32x4 (&acc)[2][2][4][2], const Unit& u, int wr, int wc, int fr, int fq) const {
        const int row0 = u.pm * BM + wr * 64 + fr; const int col0 = (u.pn & 15) * HALF + wc * 32 + 8 * fq;
#pragma unroll
        for (int ai = 0; ai < 2; ++ai)
#pragma unroll
            for (int m = 0; m < 4; ++m) { unsigned char* rowp = O + (size_t)(row0 + ai * HALF + m * 16) * FF + col0;
                const f32x4 g0 = acc[ai][0][m][0] * 0.015625f, g1 = acc[ai][0][m][1] * 0.015625f, u0 = acc[ai][1][m][0] * 0.015625f, u1 = acc[ai][1][m][1] * 0.015625f;
                u32x2 w; w.x = pk4_fp8(silu_mul(g0[0], u0[0]), silu_mul(g0[1], u0[1]), silu_mul(g0[2], u0[2]), silu_mul(g0[3], u0[3]));
                w.y = pk4_fp8(silu_mul(g1[0], u1[0]), silu_mul(g1[1], u1[1]), silu_mul(g1[2], u1[2]), silu_mul(g1[3], u1[3]));
                *(u32x2*)rowp = w; }
    }
};
struct EpiDown {
    static constexpr bool PERM = true;
    bf16_t* O; const float* gsel;
    __device__ __forceinline__ void operator()(const f32x4 (&acc)[2][2][4][2], const Unit& u, int wr, int wc, int fr, int fq) const {
        const int row0 = u.pm * BM + wr * 64 + fr; const int col0 = (u.pn & 3) * BM + wc * 32 + 8 * fq;
#pragma unroll
        for (int ai = 0; ai < 2; ++ai)
#pragma unroll
            for (int m = 0; m < 4; ++m) { const int row = row0 + ai * HALF + m * 16; const float gs = gsel[row] * 0.015625f;     bf16_t* rowp = O + (size_t)row * D + col0;
#pragma unroll
                for (int bj = 0; bj < 2; ++bj) { const f32x4 v0 = acc[ai][bj][m][0] * gs, v1 = acc[ai][bj][m][1] * gs;
                    u32x4 w; w.x = cvt_pk_bf16(v0[0], v0[1]); w.y = cvt_pk_bf16(v0[2], v0[3]); w.z = cvt_pk_bf16(v1[0], v1[1]); w.w = cvt_pk_bf16(v1[2], v1[3]);
                    *(u32x4*)(rowp + bj * HALF) = w; } }
    }
};

template <class Epi, class Sched, bool ALIGN_EPI = true, bool FP8 = false>
__device__ __forceinline__ void gemm_phase(LAS unsigned char* lds, const bf16_t* A, const bf16_t* Bt, const int K, const Sched& S, const Epi& E) {
    const int tid = opaque((int)threadIdx.x), wid = __builtin_amdgcn_readfirstlane(tid >> 6), lane = tid & 63, wr = wid >> 2, wc = wid & 3, fr = lane & 15, fq = lane >> 4;
    const int nt = K / BK;
    unsigned voffB[2];
#pragma unroll
    for (int i = 0; i < 2; ++i) { int R, C; stage_rc(tid * 16 + i * 8192, R, C); const int Rb = Epi::PERM ? ((R & ~31) + perm32(R & 31)) : R; voffB[i] = (unsigned)(Rb * K + C) * 2u; }
    const size_t kstep = (size_t)(BK * 2);
    const size_t hstep = (size_t)HALF * K * 2;
    const size_t tstep = 2 * hstep;
    const unsigned ldsw = (unsigned)wid * 1024u;
    const int aoff = lds_byte(wr * 64 + fr, fq * 8), boff = lds_byte(wc * 32 + fr, fq * 8);
#define PG8_SA(b, h) (((b) * 2 + (h)) * HTB)
#define PG8_SB(b, h) ((4 + (b) * 2 + (h)) * HTB)
#define PG8_STAGE(bufoff, gbase, voff) do { _Pragma("unroll") for (int _i = 0; _i < 2; ++_i) \
        __builtin_amdgcn_global_load_lds((const unsigned*)((const char*)(gbase) + (voff)[_i]), (LAS unsigned*)(lds + (bufoff) + ldsw + _i * 8192), 16, 0, 0); } while (0)
#define PG8_LDA(dst, b, h) do { _Pragma("unroll") for (int m = 0; m < 4; ++m) _Pragma("unroll") for (int k = 0; k < 2; ++k) dst[m][k] = *(const LAS bf16x8*)(lds + PG8_SA(b, h) + aoff + m * 2048 + k * 1024); } while (0)
#define PG8_LDB(dst, b, h) do { _Pragma("unroll") for (int n = 0; n < 2; ++n) _Pragma("unroll") for (int k = 0; k < 2; ++k) dst[n][k] = *(const LAS bf16x8*)(lds + PG8_SB(b, h) + boff + n * 2048 + k * 1024); } while (0)
#define PG8_CAT(x, y) __builtin_shufflevector(__builtin_bit_cast(v4i_t, x), __builtin_bit_cast(v4i_t, y), 0, 1, 2, 3, 4, 5, 6, 7)
#define PG8_MMA(ai, bj, At, Bt_) do { __builtin_amdgcn_s_setprio(1); \
        if constexpr (FP8) { _Pragma("unroll") for (int m = 0; m < 4; ++m) _Pragma("unroll") for (int n = 0; n < 2; ++n) \
            asm volatile("v_mfma_scale_f32_16x16x128_f8f6f4 %0, %1, %2, %0, %3, %3 op_sel_hi:[0,0,0]" : "+v"(acc[ai][bj][m][n]) : "v"(PG8_CAT(Bt_[n][0], Bt_[n][1])), "v"(PG8_CAT(At[m][0], At[m][1])), "v"(one8)); } \
        else { _Pragma("unroll") for (int m = 0; m < 4; ++m) _Pragma("unroll") for (int n = 0; n < 2; ++n) _Pragma("unroll") for (int k = 0; k < 2; ++k) \
            acc[ai][bj][m][n] = __builtin_amdgcn_mfma_f32_16x16x32_bf16(Bt_[n][k], At[m][k], acc[ai][bj][m][n], 0, 0, 0); } \
        __builtin_amdgcn_s_setprio(0); } while (0)
#define PG8_WAIT_V(n) asm volatile("s_waitcnt vmcnt(" #n ")" ::: "memory")
#define PG8_WAIT_L(n) asm volatile("s_waitcnt lgkmcnt(" #n ")" ::: "memory")
#define PG8_BAR __builtin_amdgcn_s_barrier()
#define PG8_SCHED __builtin_amdgcn_sched_barrier(0)
#define PG8_OFFS(dst, ui_, u_) do { _Pragma("unroll") for (int _h = 0; _h < 2; ++_h) _Pragma("unroll") for (int _i = 0; _i < 2; ++_i) { int R_, C_; stage_rc(tid * 16 + _i * 8192, R_, C_); dst[_h][_i] = S.row_off(ui_, u_, _h * HALF + R_) + (unsigned)C_ * 2u; } } while (0)
    Unit cur, nxt; int ui = 0;
    if (!S.next(0, cur)) return;
    f32x4 acc[2][2][4][2];
#pragma unroll
    for (int a = 0; a < 2; ++a)
#pragma unroll
        for (int b = 0; b < 2; ++b)
#pragma unroll
            for (int m = 0; m < 4; ++m)
#pragma unroll
                for (int n = 0; n < 2; ++n) acc[a][b][m][n] = (f32x4){0.f, 0.f, 0.f, 0.f};
    bf16x8 At[4][2], B0[2][2], B1[2][2];
    int one8 = 0x7f7f7f7f; asm volatile("" : "+v"(one8));
    (void)one8;
    unsigned vA[2][2];
    PG8_OFFS(vA, 0, cur);
    const char* const A0 = (const char*)A;
    const char* cB = (const char*)Bt + (size_t)cur.pn * tstep;
    PG8_STAGE(PG8_SB(0, 0), cB, voffB); PG8_STAGE(PG8_SB(0, 1), cB + hstep, voffB); PG8_STAGE(PG8_SA(0, 0), A0, vA[0]); PG8_STAGE(PG8_SA(0, 1), A0, vA[1]);
    if (wr == 1) PG8_BAR;
    PG8_WAIT_V(2); PG8_BAR;
    PG8_STAGE(PG8_SB(1, 0), cB + kstep, voffB); PG8_STAGE(PG8_SA(1, 0), A0 + kstep, vA[0]); PG8_STAGE(PG8_SB(1, 1), cB + hstep + kstep, voffB);
    PG8_WAIT_V(6); PG8_BAR;
    for (;;) {
        const bool has_next = S.next(ui + 1, nxt);
        const char* nB = has_next ? (const char*)Bt + (size_t)nxt.pn * tstep : cB;
        for (int t = 0; t < nt; t += 2) {
            const bool last = (t == nt - 2);
            const char* a1 = A0 + (size_t)(t + 1) * kstep;
            const char* a2 = last ? A0 : A0 + (size_t)(t + 2) * kstep; const char* b2 = last ? nB : cB + (size_t)(t + 2) * kstep;
            const char* a3 = a2 + kstep; const char* b3 = b2 + kstep;
            unsigned wn[2][2];
            if (last && has_next) { PG8_OFFS(wn, ui + 1, nxt); }
            else {
#pragma unroll
                for (int h = 0; h < 2; ++h)
#pragma unroll
                    for (int i = 0; i < 2; ++i) wn[h][i] = vA[h][i]; }
            unsigned (&w0)[2] = wn[0]; unsigned (&w1)[2] = wn[1];
            PG8_LDB(B0, 0, 0); PG8_LDB(B1, 0, 1); PG8_SCHED; PG8_LDA(At, 0, 0); PG8_STAGE(PG8_SA(1, 1), a1, vA[1]);
            PG8_WAIT_V(8); PG8_WAIT_L(0); PG8_BAR; PG8_MMA(0, 0, At, B0); PG8_MMA(0, 1, At, B1); PG8_BAR; PG8_SCHED;
            PG8_LDA(At, 0, 1); PG8_STAGE(PG8_SB(0, 0), b2, voffB); PG8_STAGE(PG8_SB(0, 1), b2 + hstep, voffB); PG8_STAGE(PG8_SA(0, 0), a2, w0);
            PG8_WAIT_V(8); PG8_WAIT_L(0); PG8_BAR; PG8_MMA(1, 0, At, B0); PG8_MMA(1, 1, At, B1); PG8_BAR; PG8_SCHED;
            PG8_LDB(B0, 1, 0); PG8_LDB(B1, 1, 1); PG8_SCHED; PG8_LDA(At, 1, 0); PG8_STAGE(PG8_SA(0, 1), a2, w1);
            PG8_WAIT_V(8); PG8_WAIT_L(0); PG8_BAR; PG8_MMA(0, 0, At, B0); PG8_MMA(0, 1, At, B1); PG8_BAR; PG8_SCHED;
            PG8_LDA(At, 1, 1); PG8_STAGE(PG8_SB(1, 0), b3, voffB); PG8_STAGE(PG8_SB(1, 1), b3 + hstep, voffB); PG8_STAGE(PG8_SA(1, 0), a3, w0);
            PG8_WAIT_V(8); PG8_WAIT_L(0); PG8_BAR; PG8_MMA(1, 0, At, B0); PG8_MMA(1, 1, At, B1); PG8_BAR; PG8_SCHED;
        }
        if constexpr (FP8) asm volatile("s_nop 15\n\ts_nop 15" ::: "memory");
        if constexpr (ALIGN_EPI) { if (wr == 0) PG8_BAR; }
        E(acc, cur, wr, wc, fr, fq);
        if (!has_next) break;
#pragma unroll
        for (int a = 0; a < 2; ++a)
#pragma unroll
            for (int b = 0; b < 2; ++b)
#pragma unroll
                for (int m = 0; m < 4; ++m)
#pragma unroll
                    for (int n = 0; n < 2; ++n) acc[a][b][m][n] = (f32x4){0.f, 0.f, 0.f, 0.f};
        cur = nxt; cB = nB; ++ui;
        PG8_OFFS(vA, ui, cur);
        if constexpr (ALIGN_EPI) { if (wr == 1) PG8_BAR; }
    }
    PG8_WAIT_V(0);
    if constexpr (!ALIGN_EPI) { if (wr == 0) PG8_BAR; }
    PG8_BAR;
#undef PG8_SA
#undef PG8_SB
#undef PG8_STAGE
#undef PG8_LDA
#undef PG8_LDB
#undef PG8_MMA
#undef PG8_CAT
#undef PG8_WAIT_V
#undef PG8_WAIT_L
#undef PG8_BAR
#undef PG8_SCHED
#undef PG8_OFFS
}
}

#define XB_TMO      128
#define XB_XCNT(j)  (256  + 64 * (j))
#define XB_XSUB(j)  (1280 + 64 * (j))
#define XB_XGEN(j)  (2304 + 64 * (j))
#define XB_TOP      3328
#define XB_TOPGEN   3392
#define XCD_BAR_WORDS 3456
#define XB_SPIN_CAP (1u << 18)
__device__ __forceinline__ unsigned xb_ld(unsigned* p)              { return __hip_atomic_load(p, __ATOMIC_RELAXED, __HIP_MEMORY_SCOPE_AGENT); }
__device__ __forceinline__ unsigned xb_add(unsigned* p, unsigned v) { return __hip_atomic_fetch_add(p, v, __ATOMIC_RELAXED, __HIP_MEMORY_SCOPE_AGENT); }
__device__ __forceinline__ unsigned xb_xcc_id() { return (unsigned)__builtin_amdgcn_s_getreg((3 << 11) | 20) & 0xFu; }
#define XB_SPIN(cond, bar) do { unsigned _sp = 0; while (cond) { __builtin_amdgcn_s_sleep(1); \
    if ((++_sp & 255u) == 0u) { if (xb_ld(&(bar)[XB_TMO])) break; if (_sp > XB_SPIN_CAP) { atomicAdd(&(bar)[XB_TMO], 1u); break; } } } } while (0)
struct XcdBarrier { unsigned* bar; unsigned x; volatile LAS unsigned* st; };
__device__ __forceinline__ XcdBarrier xcd_barrier_post(unsigned* bar, volatile LAS unsigned* st) {
    XcdBarrier b; b.bar = bar; b.x = xb_xcc_id(); b.st = st;
    if (threadIdx.x == 0) (void)xb_add(&bar[XB_XCNT(b.x)], 1u);
    return b;
}
__device__ __forceinline__ void xcd_barrier_complete(unsigned* bar, unsigned x, unsigned& nloc, unsigned& nx) {
    const unsigned G = gridDim.x * gridDim.y * gridDim.z;
    unsigned sum, cnt, mine, sp = 0u;
    for (;;) {
        sum = 0u; cnt = 0u; mine = 0u;
#pragma unroll
        for (unsigned j = 0; j < 16; ++j) { const unsigned c = xb_ld(&bar[XB_XCNT(j)]); sum += c; cnt += (c > 0u) ? 1u : 0u; mine = (j == x) ? c : mine; }
        if (sum == G) break;
        __builtin_amdgcn_s_sleep(1);
        if ((++sp & 255u) == 0u) { if (xb_ld(&bar[XB_TMO])) break; if (sp > XB_SPIN_CAP) { atomicAdd(&bar[XB_TMO], 1u); break; } }
    }
    nloc = mine > 0u ? mine : 1u; nx = cnt > 0u ? cnt : 1u;
}
__device__ __forceinline__ void xcd_barrier(const XcdBarrier& b) {
    asm volatile("s_waitcnt vmcnt(0)" ::: "memory");
    __syncthreads();
    if (threadIdx.x == 0) {
        unsigned* bar = b.bar; unsigned bx_ = b.x; asm volatile("" : "+s"(bx_));
        __builtin_amdgcn_s_waitcnt(0);
        unsigned nloc = b.st[0], nx = b.st[1];
        if (nloc == 0u) { xcd_barrier_complete(bar, bx_, nloc, nx); b.st[0] = nloc; b.st[1] = nx; }
        const unsigned old = xb_add(&bar[XB_XSUB(bx_)], 1u);
        const unsigned gen = old / nloc;
        if (old + 1u == (gen + 1u) * nloc) {
            __builtin_amdgcn_fence(__ATOMIC_RELEASE, "agent");
            asm volatile("s_waitcnt vmcnt(0)" ::: "memory");
            const unsigned og = xb_add(&bar[XB_TOP], 1u);
            const unsigned tg = og / nx;
            if (og + 1u == (tg + 1u) * nx) xb_add(&bar[XB_TOPGEN], 1u);
            else XB_SPIN(xb_ld(&bar[XB_TOPGEN]) == tg, bar);
            __builtin_amdgcn_fence(__ATOMIC_ACQUIRE, "agent");
            xb_add(&bar[XB_XGEN(bx_)], 1u);
            asm volatile("s_waitcnt vmcnt(0)" ::: "memory");
        } else {
            XB_SPIN(xb_ld(&bar[XB_XGEN(bx_)]) == gen, bar);
            __builtin_amdgcn_fence(__ATOMIC_ACQUIRE, "agent");
            asm volatile("s_waitcnt vmcnt(0)" ::: "memory");
        }
    }
    __syncthreads();
}

struct Params {
    const float *x, *c, *ada_w, *ada_b, *norm_g, *na_w_qkv, *na_w_o, *na_rpb, *sw_w_qkv, *sw_w_o, *sw_sinks, *t5_bias, *w_router, *w_gate, *w_up, *w_down, *final_g;
    float* out; unsigned char* ws;
};

typedef const __attribute__((address_space(4))) Params KP;
__device__ __forceinline__ KP* kparams() { unsigned long long k = (unsigned long long)__builtin_amdgcn_kernarg_segment_ptr(); asm volatile("" : "+s"(k)); return (KP*)k; }

__device__ __forceinline__ void p0_mod_item(const float* __restrict__ cvec, const float* __restrict__ ada_w, const float* __restrict__ ada_b, LAS unsigned char* lds, int item, int tid, int wave, int lane, float* mod) {
    LAS float* sc = (LAS float*)lds;
    LAS float* red = (LAS float*)(lds + 32768);
    for (int i = tid; i < 8192; i += 512) { const int b = i >> 10, k = i & 1023; const float v = cvec[b * 1024 + k]; sc[k * 8 + b] = v / (1.f + expf(-v)); }
    __syncthreads();
    const int l = item / 48, nb = item % 48, n0 = nb * 128;
    const int colq = lane & 31, kpar = lane >> 5, s16 = wave * 2 + kpar;
    const float* wp = ada_w + ((size_t)l * 1024 + s16 * 64) * 6144 + n0 + 4 * colq;
    float acc[8][4];
#pragma unroll
    for (int b = 0; b < 8; ++b)
#pragma unroll
        for (int j = 0; j < 4; ++j) acc[b][j] = 0.f;
#pragma unroll 8
    for (int kk = 0; kk < 64; ++kk) {
        const f32x4 w4 = *(const f32x4*)(wp + (size_t)kk * 6144);
        const int k = s16 * 64 + kk;
        const f32x4 s0 = *(const LAS f32x4*)(sc + k * 8), s1 = *(const LAS f32x4*)(sc + k * 8 + 4);
#pragma unroll
        for (int b = 0; b < 4; ++b)
#pragma unroll
            for (int j = 0; j < 4; ++j) { acc[b][j] += s0[b] * w4[j]; acc[4 + b][j] += s1[b] * w4[j]; }
    }
#pragma unroll
    for (int b = 0; b < 8; ++b) *(LAS f32x4*)(red + ((s16 * 8 + b) * 128 + 4 * colq)) = (f32x4){acc[b][0], acc[b][1], acc[b][2], acc[b][3]};
    __syncthreads();
#pragma unroll
    for (int q = 0; q < 2; ++q) { const int o = tid + 512 * q, b = o >> 7, col = o & 127; float s = ada_b[l * 6144 + n0 + col];
#pragma unroll
        for (int k = 0; k < 16; ++k) s += red[(k * 8 + b) * 128 + col];
        mod[(size_t)(l * 8 + b) * 6144 + n0 + col] = s; }
    __syncthreads();
}
constexpr int CONV_ROW = 144, CONV_TILE = 64 * CONV_ROW;
__device__ __forceinline__ void conv_item(const float* __restrict__ src, int N, int K, int n0, int k0, bf16_t* __restrict__ dst, int mode, float scale, LAS unsigned char* tile, int lane) {
    const int n4 = lane & 15, kr = lane >> 4;
    const float* sp = src + (size_t)(k0 + 16 * kr) * N + n0 + 4 * n4;
    const int rn = lane >> 3, rc = lane & 7;
    size_t rowo[8];
#pragma unroll
    for (int ps = 0; ps < 8; ++ps) { const int nn = n0 + 8 * ps + rn; const int row = (mode == 0) ? nn : ((nn >> 7) * 256 + (nn & 127) + (mode == 2 ? 128 : 0)); rowo[ps] = (size_t)row * K + k0 + 8 * rc; }
#pragma unroll 1
    for (int step = 0; step < 4; ++step) {
        f32x4 v[16];
#pragma unroll
        for (int i = 0; i < 16; ++i) v[i] = __builtin_nontemporal_load((const f32x4*)(sp + (size_t)(step * 64 + i) * N));
#pragma unroll
        for (int j = 0; j < 4; ++j)
#pragma unroll
            for (int hf = 0; hf < 2; ++hf) { u32x4 w;
                w.x = cvt_pk_bf16(v[hf * 8 + 0][j] * scale, v[hf * 8 + 1][j] * scale); w.y = cvt_pk_bf16(v[hf * 8 + 2][j] * scale, v[hf * 8 + 3][j] * scale);
                w.z = cvt_pk_bf16(v[hf * 8 + 4][j] * scale, v[hf * 8 + 5][j] * scale); w.w = cvt_pk_bf16(v[hf * 8 + 6][j] * scale, v[hf * 8 + 7][j] * scale);
                *(LAS u32x4*)(tile + (4 * n4 + j) * CONV_ROW + kr * 32 + hf * 16) = w; }
#pragma unroll
        for (int ps = 0; ps < 8; ++ps) { const u32x4 w = *(const LAS u32x4*)(tile + (8 * ps + rn) * CONV_ROW + rc * 16);
            __builtin_nontemporal_store(w, (u32x4*)(dst + rowo[ps] + step * 64)); }
    }
}
__device__ __forceinline__ void conv_item8(const float* __restrict__ src, int N, int K, int n0, int k0, unsigned char* __restrict__ dst, int mode, LAS unsigned char* tile, int lane) {
    const int n4 = lane & 15, kr = lane >> 4;
    const float* sp = src + (size_t)(k0 + 16 * kr) * N + n0 + 4 * n4;
    const int rn = lane >> 3, rc = lane & 7;
#pragma unroll 1
    for (int pair = 0; pair < 2; ++pair) {
#pragma unroll
        for (int hs = 0; hs < 2; ++hs) {
            f32x4 v[16];
#pragma unroll
            for (int i = 0; i < 16; ++i) v[i] = __builtin_nontemporal_load((const f32x4*)(sp + (size_t)((pair * 2 + hs) * 64 + i) * N)) * 64.0f;
#pragma unroll
            for (int j = 0; j < 4; ++j) { u32x4 w;
                w.x = pg8::pk4_fp8(v[0][j], v[1][j], v[2][j], v[3][j]); w.y = pg8::pk4_fp8(v[4][j], v[5][j], v[6][j], v[7][j]);
                w.z = pg8::pk4_fp8(v[8][j], v[9][j], v[10][j], v[11][j]); w.w = pg8::pk4_fp8(v[12][j], v[13][j], v[14][j], v[15][j]);
                *(LAS u32x4*)(tile + (4 * n4 + j) * CONV_ROW + hs * 64 + kr * 16) = w; }
        }
#pragma unroll
        for (int ps = 0; ps < 8; ++ps) { const u32x4 w = *(const LAS u32x4*)(tile + (8 * ps + rn) * CONV_ROW + rc * 16);
            const int nn = n0 + 8 * ps + rn; const int row = (mode == 0) ? nn : ((nn >> 7) * 256 + (nn & 127) + (mode == 2 ? 128 : 0));
            __builtin_nontemporal_store(w, (u32x4*)(dst + (size_t)row * K + k0 + pair * 128 + 16 * rc)); }
    }
}
constexpr int CONV_ITEMS = 12704;
constexpr int CONV_LATE0 = 2048, CONV_LATE = 1024, CONV_P0 = CONV_ITEMS - CONV_LATE;
__device__ __forceinline__ void conv_dispatch(KP* kp, int it, LAS unsigned char* tile, int lane) {
    unsigned char* ws = kp->ws;
    if (it < 8192) {
        const int up = it >> 12, r0 = it & 4095, le = r0 >> 7, r = r0 & 127, kc = r >> 5, nb = r & 31;
        const float* src = (up ? kp->w_up : kp->w_gate) + (size_t)le * 1024 * 2048;
        conv_item8(src, 2048, 1024, nb * 64, kc * 256, ws + WS_WGU + (size_t)le * 4096 * 1024, up ? 2 : 1, tile, lane);
    } else if (it < 12288) {
        const int r0 = it - 8192, le = r0 >> 7, r = r0 & 127, kc = r >> 4, nb = r & 15;
        conv_item8(kp->w_down + (size_t)le * 2048 * 1024, 1024, 2048, nb * 64, kc * 256, ws + WS_WD + (size_t)le * 1024 * 2048, 0, tile, lane);
    } else if (it < 12480) { const int r = it - 12288, nb = r >> 2, kc = r & 3;
        conv_item(kp->na_w_qkv, 3072, 1024, nb * 64, kc * 256, (bf16_t*)(ws + WS_WQK0), 0, nb < 16 ? 0.125f : 1.f, tile, lane);
    } else if (it < 12544) { const int r = it - 12480, nb = r >> 2, kc = r & 3;
        conv_item(kp->na_w_o, 1024, 1024, nb * 64, kc * 256, (bf16_t*)(ws + WS_WO0), 0, 1.f, tile, lane);
    } else if (it < 12640) { const int r = it - 12544, nb = r >> 2, kc = r & 3;
        conv_item(kp->sw_w_qkv, 1536, 1024, nb * 64, kc * 256, (bf16_t*)(ws + WS_WQK1), 0, nb < 16 ? 0.125f : 1.f, tile, lane);
    } else { const int r = it - 12640, nb = r >> 2, kc = r & 3;
        conv_item(kp->sw_w_o, 1024, 1024, nb * 64, kc * 256, (bf16_t*)(ws + WS_WO1), 0, 1.f, tile, lane);
    }
}

__device__ __forceinline__ void row_phase(KP* kp, int mode, int l, int gw, int lane) {
    unsigned char* ws = kp->ws; const float* px = kp->x; const float* norm_g = kp->norm_g; const float* final_g = kp->final_g; float* outp = kp->out;
    const float* mod = (const float*)(ws + WS_MOD);
    float* XA = (float*)(ws + WS_XA); bf16_t* H = (bf16_t*)(ws + WS_H);
    const int* SLOT = (const int*)(ws + WS_SLOT); const bf16_t* Y = (const bf16_t*)(ws + WS_Y);
    const int row0 = gw * 8, b = row0 >> 11;
    const float* xin = (mode == 0) ? px : XA;
    f32x4 Av[4], Bv[4], G2[4];
#pragma unroll
    for (int j = 0; j < 4; ++j) { const int col = 4 * lane + 256 * j;
        if (mode < 2) { const f32x4 g = *(const f32x4*)(norm_g + (size_t)(l * 2 + 0) * D + col); const float* mb = mod + (size_t)(l * 8 + b) * 6144;
            const f32x4 sc = *(const f32x4*)(mb + D + col), sh = *(const f32x4*)(mb + col); Av[j] = g * (sc + 1.0f); Bv[j] = sh; }
        else { Av[j] = *(const f32x4*)(final_g + col); Bv[j] = (f32x4){0.f, 0.f, 0.f, 0.f}; }
        if (mode > 0) { const int lp = (mode == 1) ? (l - 1) : 1; G2[j] = *(const f32x4*)(mod + (size_t)(lp * 8 + b) * 6144 + 5 * D + col); }
        else G2[j] = (f32x4){0.f, 0.f, 0.f, 0.f}; }
    for (int r = 0; r < 8; ++r) {
        const int row = row0 + r;
        f32x4 v[4];
#pragma unroll
        for (int j = 0; j < 4; ++j) v[j] = *(const f32x4*)(xin + (size_t)row * D + 4 * lane + 256 * j);
        if (mode > 0) {
            const int sv = SLOT[(size_t)row * 16 + (lane & 15)];
            f32x4 a[4];
#pragma unroll
            for (int j = 0; j < 4; ++j) a[j] = (f32x4){0.f, 0.f, 0.f, 0.f};
#pragma unroll
            for (int e = 0; e < 16; ++e) { const int s = __builtin_amdgcn_readlane(sv, e);
                if (s >= 0) { const bf16_t* yr = Y + (size_t)((b * 16 + e) * 256 + s) * D + 4 * lane;
#pragma unroll
                    for (int j = 0; j < 4; ++j) { const u32x2 w = *(const u32x2*)(yr + 256 * j); a[j] += (f32x4){bf_lo(w.x), bf_hi(w.x), bf_lo(w.y), bf_hi(w.y)}; } } }
#pragma unroll
            for (int j = 0; j < 4; ++j) v[j] += G2[j] * a[j];
            if (mode == 1) {
#pragma unroll
                for (int j = 0; j < 4; ++j) *(f32x4*)(XA + (size_t)row * D + 4 * lane + 256 * j) = v[j]; }
        }
        float ss = 0.f;
#pragma unroll
        for (int j = 0; j < 4; ++j) ss += (v[j].x * v[j].x + v[j].y * v[j].y) + (v[j].z * v[j].z + v[j].w * v[j].w);
        const float rstd = 1.0f / sqrtf(wave_sum(ss) * (1.0f / D) + RMS_EPS);
        if (mode < 2) {
#pragma unroll
            for (int j = 0; j < 4; ++j) { const f32x4 o = v[j] * rstd * Av[j] + Bv[j]; u32x2 w; w.x = cvt_pk_bf16(o[0], o[1]); w.y = cvt_pk_bf16(o[2], o[3]);
                *(u32x2*)(H + (size_t)row * D + 4 * lane + 256 * j) = w; }
        } else {
#pragma unroll
            for (int j = 0; j < 4; ++j) *(f32x4*)(outp + (size_t)row * D + 4 * lane + 256 * j) = v[j] * rstd * Av[j];
        }
    }
}

__device__ __forceinline__ float reduce16(const float (&p)[16], int lane) {
    const bool b5 = lane & 32, b4 = lane & 16, b3 = lane & 8, b2 = lane & 4;
    float q[8], r[4], s[2];
#pragma unroll
    for (int i = 0; i < 8; ++i) { const float keep = b5 ? p[8 + i] : p[i], send = b5 ? p[i] : p[8 + i]; q[i] = keep + __shfl_xor(send, 32); }
#pragma unroll
    for (int i = 0; i < 4; ++i) { const float keep = b4 ? q[4 + i] : q[i], send = b4 ? q[i] : q[4 + i]; r[i] = keep + __shfl_xor(send, 16); }
#pragma unroll
    for (int i = 0; i < 2; ++i) { const float keep = b3 ? r[2 + i] : r[i], send = b3 ? r[i] : r[2 + i]; s[i] = keep + __shfl_xor(send, 8); }
    const float keep = b2 ? s[1] : s[0], send = b2 ? s[0] : s[1];
    float t = keep + __shfl_xor(send, 4);
    t += __shfl_xor(t, 2); t += __shfl_xor(t, 1);
    return t;
}
__device__ __forceinline__ void router_phase(KP* kp, int l, LAS unsigned char* lds, int gw, int tid, int lane) {
    unsigned char* ws = kp->ws; const float* w_router = kp->w_router; const float* norm_g = kp->norm_g;
    const float* mod = (const float*)(ws + WS_MOD);
    const float* XA = (const float*)(ws + WS_XA); unsigned char* H8 = ws + WS_H;
    float* AFF = (float*)(ws + WS_AFF); int* SLOT = (int*)(ws + WS_SLOT);
    LAS float* wrT = (LAS float*)lds;
    for (int i = tid; i < 4096; i += 512) { const int k = i >> 2, e4 = i & 3; const f32x4 v = *(const f32x4*)(w_router + (size_t)l * 16384 + k * 16 + 4 * e4);
#pragma unroll
        for (int j = 0; j < 4; ++j) wrT[(4 * e4 + j) * 1024 + (k ^ (e4 << 3))] = v[j]; }
    __syncthreads();
    const int row0 = gw * 8, b = row0 >> 11;
    f32x4 Av[4], Bv[4];
#pragma unroll
    for (int j = 0; j < 4; ++j) { const int col = 4 * lane + 256 * j; const f32x4 g = *(const f32x4*)(norm_g + (size_t)(l * 2 + 1) * D + col); const float* mb = mod + (size_t)(l * 8 + b) * 6144;
        const f32x4 sc = *(const f32x4*)(mb + 4 * D + col), sh = *(const f32x4*)(mb + 3 * D + col); Av[j] = g * (sc + 1.0f); Bv[j] = sh; }
    const int e_l = ((lane >> 5) & 1) * 8 + ((lane >> 4) & 1) * 4 + ((lane >> 3) & 1) * 2 + ((lane >> 2) & 1);
#pragma unroll 1
    for (int rq = 0; rq < 2; ++rq) {
        const int rb = row0 + 4 * rq;
        f32x4 ha[4][4];
#pragma unroll
        for (int r = 0; r < 4; ++r)
#pragma unroll
            for (int j = 0; j < 4; ++j) ha[r][j] = *(const f32x4*)(XA + (size_t)(rb + r) * D + 4 * lane + 256 * j);
        float sa[4];
#pragma unroll
        for (int r = 0; r < 4; ++r) { float t = 0.f;
#pragma unroll
            for (int j = 0; j < 4; ++j) t += (ha[r][j].x * ha[r][j].x + ha[r][j].y * ha[r][j].y) + (ha[r][j].z * ha[r][j].z + ha[r][j].w * ha[r][j].w);
            sa[r] = t; }
#pragma unroll
        for (int o = 1; o < 64; o <<= 1) {
#pragma unroll
            for (int r = 0; r < 4; ++r) sa[r] += __shfl_xor(sa[r], o); }
#pragma unroll
        for (int r = 0; r < 4; ++r) { const float rs = 1.0f / sqrtf(sa[r] * (1.0f / D) + RMS_EPS);
#pragma unroll
            for (int j = 0; j < 4; ++j) { ha[r][j] = ha[r][j] * rs * Av[j] + Bv[j];
                *(unsigned*)(H8 + (size_t)(rb + r) * D + 4 * lane + 256 * j) = pg8::pk4_fp8(ha[r][j][0], ha[r][j][1], ha[r][j][2], ha[r][j][3]); } }
        float pa[4][16];
#pragma unroll
        for (int e = 0; e < 16; ++e) { float x0 = 0.f, x1 = 0.f, x2 = 0.f, x3 = 0.f;
#pragma unroll
            for (int j = 0; j < 4; ++j) { const f32x4 w = *(const LAS f32x4*)(wrT + e * 1024 + ((4 * lane + 256 * j) ^ ((e >> 2) << 3)));
                x0 += (ha[0][j].x * w.x + ha[0][j].y * w.y) + (ha[0][j].z * w.z + ha[0][j].w * w.w); x1 += (ha[1][j].x * w.x + ha[1][j].y * w.y) + (ha[1][j].z * w.z + ha[1][j].w * w.w);
                x2 += (ha[2][j].x * w.x + ha[2][j].y * w.y) + (ha[2][j].z * w.z + ha[2][j].w * w.w); x3 += (ha[3][j].x * w.x + ha[3][j].y * w.y) + (ha[3][j].z * w.z + ha[3][j].w * w.w); }
            pa[0][e] = x0; pa[1][e] = x1; pa[2][e] = x2; pa[3][e] = x3; if ((e & 3) == 3) asm volatile("" ::: "memory"); }
        float lg[4], mx[4], ex[4], sm[4];
#pragma unroll
        for (int r = 0; r < 4; ++r) { lg[r] = reduce16(pa[r], lane); mx[r] = lg[r]; }
#pragma unroll
        for (int o = 4; o < 64; o <<= 1) {
#pragma unroll
            for (int r = 0; r < 4; ++r) mx[r] = fmaxf(mx[r], __shfl_xor(mx[r], o)); }
#pragma unroll
        for (int r = 0; r < 4; ++r) { ex[r] = __builtin_amdgcn_exp2f((lg[r] - mx[r]) * LOG2E); sm[r] = ex[r]; }
#pragma unroll
        for (int o = 4; o < 64; o <<= 1) {
#pragma unroll
            for (int r = 0; r < 4; ++r) sm[r] += __shfl_xor(sm[r], o); }
#pragma unroll
        for (int r = 0; r < 4; ++r) {
            if ((lane & 3) == 0) AFF[(size_t)(b * 16 + e_l) * 2048 + ((rb + r) & 2047)] = ex[r] / sm[r];
            if (lane < 16) SLOT[(size_t)(rb + r) * 16 + lane] = -1; }
    }
}
__device__ __forceinline__ int wave_isum(int v) {
    v += __builtin_amdgcn_update_dpp(0, v, 0xB1, 0xF, 0xF, true);
    v += __builtin_amdgcn_update_dpp(0, v, 0x4E, 0xF, 0xF, true);
    v += __builtin_amdgcn_update_dpp(0, v, 0x141, 0xF, 0xF, true);
    v += __builtin_amdgcn_update_dpp(0, v, 0x140, 0xF, 0xF, true);
    return __builtin_amdgcn_readlane(v, 0) + __builtin_amdgcn_readlane(v, 16) + __builtin_amdgcn_readlane(v, 32) + __builtin_amdgcn_readlane(v, 48);
}
__device__ __forceinline__ void topk_task(unsigned char* ws, int task, int lane, LAS unsigned* tab, bool pub) {
    const float* AFF = (const float*)(ws + WS_AFF); int* SLOT = (int*)(ws + WS_SLOT); float* GSEL = (float*)(ws + WS_GSEL);
    const int b = task >> 4, e = task & 15;
    unsigned u[32];
#pragma unroll
    for (int j = 0; j < 32; ++j) u[j] = __float_as_uint(AFF[(size_t)task * 2048 + 64 * j + lane]);
    unsigned Tv = 0u;
#pragma unroll 1
    for (int bit = 29; bit >= 0; --bit) {
        const unsigned cand = Tv | (1u << bit); int cnt = 0;
#pragma unroll
        for (int j = 0; j < 32; ++j) cnt += (u[j] >= cand) ? 1 : 0;
        const int c = wave_isum(cnt);
        if (c >= CAP) { Tv = cand; if (c == CAP) break; }
    }
    int cgt = 0;
#pragma unroll
    for (int j = 0; j < 32; ++j) cgt += (u[j] > Tv) ? 1 : 0;
    int quota = CAP - wave_isum(cgt), base = 0;
    const unsigned long long lt = (1ull << lane) - 1ull;
#pragma unroll
    for (int j = 0; j < 32; ++j) {
        const bool gt = u[j] > Tv, eq = u[j] == Tv;
        const unsigned long long em = __ballot(eq);
        const int erank = __popcll(em & lt);
        const bool sel = gt || (eq && erank < quota);
        const int ne = __popcll(em); quota -= (ne < quota ? ne : quota);
        const unsigned long long sm = __ballot(sel);
        const int slot = base + __popcll(sm & lt);
        if (sel) { const int tokrow = b * 2048 + 64 * j + lane;
            tab[slot] = (unsigned)tokrow * 1024u;
            if (pub) { GSEL[task * 256 + slot] = __uint_as_float(u[j]); SLOT[(size_t)tokrow * 16 + e] = slot; } }
        base += __popcll(sm);
    }
}

__device__ __forceinline__ bf16x8 pack8(const f32x4& a, const f32x4& b) {
    u32x4 w; w.x = cvt_pk_bf16(a[0], a[1]); w.y = cvt_pk_bf16(a[2], a[3]); w.z = cvt_pk_bf16(b[0], b[1]); w.w = cvt_pk_bf16(b[2], b[3]); return __builtin_bit_cast(bf16x8, w); }
__device__ __forceinline__ bf16x8 lds_k(const LAS unsigned char* Kl, int kl, int c) { return *(const LAS bf16x8*)(Kl + kl * 128 + ((c ^ ((kl >> 1) & 7)) << 4)); }
__device__ __forceinline__ bf16x8 lds_v(const LAS unsigned char* vp) { const bf16x4 a = *(const LAS bf16x4*)vp, b = *(const LAS bf16x4*)(vp + 32); return (bf16x8){a[0], a[1], a[2], a[3], b[0], b[1], b[2], b[3]}; }

#define ATT_SB() __builtin_amdgcn_sched_barrier(0)
template <int NT, int GS, class CO, class CA>
__device__ __forceinline__ void att_qk(f32x4 (&S)[NT], const LAS unsigned char* kb0, const LAS unsigned char* kb1, const LAS float* ctab, const bf16x8 Q0, const bf16x8 Q1, const CO& coff, const CA& cadd) {
    constexpr int NG = NT / GS;
    bf16x8 fa[2][GS], fb[2][GS]; f32x4 ci[2][GS];
#define ATT_LD(set, grp) do { _Pragma("unroll") for (int tt = 0; tt < GS; ++tt) { const int t = (grp) * GS + tt; \
        fa[set][tt] = *(const LAS bf16x8*)(kb0 + t * 2048); fb[set][tt] = *(const LAS bf16x8*)(kb1 + t * 2048); const LAS float* cp = ctab + coff(t); \
        ci[set][tt] = (f32x4){cp[0], cp[1], cp[2], cp[3]}; } } while (0)
    ATT_LD(0, 0);
#pragma unroll
    for (int grp = 0; grp < NG; ++grp) {
        const int cur = grp & 1;
        if (grp + 1 < NG) { if (cur == 0) ATT_LD(1, grp + 1); else ATT_LD(0, grp + 1); }
        ATT_SB();
#pragma unroll
        for (int tt = 0; tt < GS; ++tt) { const int t = grp * GS + tt; S[t] = __builtin_amdgcn_mfma_f32_16x16x32_bf16(fa[cur][tt], Q0, cadd(t, ci[cur][tt]), 0, 0, 0); }
#pragma unroll
        for (int tt = 0; tt < GS; ++tt) { const int t = grp * GS + tt; S[t] = __builtin_amdgcn_mfma_f32_16x16x32_bf16(fb[cur][tt], Q1, S[t], 0, 0, 0); }
        ATT_SB();
    }
#undef ATT_LD
}
template <int NT>
__device__ __forceinline__ float att_softmax(f32x4 (&S)[NT], float extra) {
    float m0 = extra, m1 = -3.0e38f;
#pragma unroll
    for (int t = 0; t < NT; ++t) { m0 = fmaxf(m0, fmaxf(S[t][0], S[t][1])); m1 = fmaxf(m1, fmaxf(S[t][2], S[t][3])); }
    float mx = fmaxf(m0, m1);
    mx = fmaxf(mx, __shfl_xor(mx, 16)); mx = fmaxf(mx, __shfl_xor(mx, 32));
    const float nm = -mx * LOG2E;
    float s0 = 0.f, s1 = 0.f;
#pragma unroll
    for (int t = 0; t < NT; ++t) {
        const float e0 = __builtin_amdgcn_exp2f(__builtin_fmaf(S[t][0], LOG2E, nm)), e1 = __builtin_amdgcn_exp2f(__builtin_fmaf(S[t][1], LOG2E, nm));
        const float e2 = __builtin_amdgcn_exp2f(__builtin_fmaf(S[t][2], LOG2E, nm)), e3 = __builtin_amdgcn_exp2f(__builtin_fmaf(S[t][3], LOG2E, nm));
        S[t] = (f32x4){e0, e1, e2, e3}; s0 += e0 + e1; s1 += e2 + e3; }
    float sum = s0 + s1;
    sum += __shfl_xor(sum, 16); sum += __shfl_xor(sum, 32);
    return sum + __builtin_amdgcn_exp2f(__builtin_fmaf(extra, LOG2E, nm));
}
template <int NG2, int ROWV, int NT>
__device__ __forceinline__ void att_pv(f32x4 (&Oa)[4], const f32x4 (&S)[NT], const LAS unsigned char* vb) {
    bf16x4 va[2][4], vc[2][4];
#define ATT_LV(set, gi) do { _Pragma("unroll") for (int dt = 0; dt < 4; ++dt) { const LAS unsigned char* vp = vb + (gi) * 64 + dt * 16 * ROWV; \
        va[set][dt] = *(const LAS bf16x4*)vp; vc[set][dt] = *(const LAS bf16x4*)(vp + 32); } } while (0)
    ATT_LV(0, 0);
#pragma unroll
    for (int gi = 0; gi < NG2; ++gi) {
        const int cur = gi & 1;
        if (gi + 1 < NG2) { if (cur == 0) ATT_LV(1, gi + 1); else ATT_LV(0, gi + 1); }
        const bf16x8 Pf = pack8(S[2 * gi], S[2 * gi + 1]);
        ATT_SB();
#pragma unroll
        for (int dt = 0; dt < 4; ++dt) { const bf16x4 x = va[cur][dt], y = vc[cur][dt];
            Oa[dt] = __builtin_amdgcn_mfma_f32_16x16x32_bf16((bf16x8){x[0], x[1], x[2], x[3], y[0], y[1], y[2], y[3]}, Pf, Oa[dt], 0, 0, 0); }
        ATT_SB();
    }
#undef ATT_LV
}

constexpr int NA_KEYS = 480, NA_ROWV = 976, NA_K_BYTES = NA_KEYS * 128, NA_V_OFF = NA_K_BYTES, NA_BIAS_OFF = NA_V_OFF + 64 * NA_ROWV;
static_assert(NA_BIAS_OFF + 15 * 64 * 4 <= RING_BYTES, "NA LDS map");
__device__ __forceinline__ void na_unit(const bf16x8 Q0, const bf16x8 Q1, bf16_t* __restrict__ O, const LAS unsigned char* lds, int b, int r, int h, int n, int kr0, int lane) {
    const int qi = lane & 15, g = lane >> 4, sw = (qi >> 1) & 7;
    const int tq = b * 2048 + r * 64 + 16 * n;
    const int rs = min(max(r - 4, 0), 24), kstart = min(max(16 * n - 8, 0), 32), ro = rs - kr0;
    const LAS unsigned char* kb0 = lds + (ro * 32 + qi) * 128 + ((g ^ sw) << 4);
    const LAS unsigned char* kb1 = lds + (ro * 32 + qi) * 128 + (((g + 4) ^ sw) << 4);
    const LAS unsigned char* vb = lds + NA_V_OFF + qi * NA_ROWV + (ro * 32 + 4 * g) * 2;
    const LAS float* rpbT = (const LAS float*)(lds + NA_BIAS_OFF) + (rs - r + 7) * 64 + (kstart + 4 * g - (16 * n + qi) + 31);
    const int qc = 16 * n + qi, cstart = min(max(qc - 8, 0), 48), kc0 = kstart + 4 * g - cstart;
    f32x4 madd[2];
#pragma unroll
    for (int c = 0; c < 2; ++c)
#pragma unroll
        for (int q = 0; q < 4; ++q) madd[c][q] = ((unsigned)(kc0 + 16 * c + q) < 16u) ? 0.f : -1.0e30f;
    f32x4 S[16];
    att_qk<16, 2>(S, kb0, kb1, rpbT, Q0, Q1, [](int t) { return (t >> 1) * 64 + (t & 1) * 16; }, [&](int t, const f32x4& c) { return c + madd[t & 1]; });
    const float sum = att_softmax<16>(S, -3.0e38f);
    f32x4 Oa[4];
#pragma unroll
    for (int dt = 0; dt < 4; ++dt) Oa[dt] = (f32x4){0.f, 0.f, 0.f, 0.f};
    att_pv<8, NA_ROWV, 16>(Oa, S, vb);
    const float inv = 1.0f / sum;
#pragma unroll
    for (int dt = 0; dt < 4; ++dt) { u32x2 w; w.x = cvt_pk_bf16(Oa[dt][0] * inv, Oa[dt][1] * inv); w.y = cvt_pk_bf16(Oa[dt][2] * inv, Oa[dt][3] * inv);
        *(u32x2*)(O + (size_t)(tq + qi) * D + h * 64 + 16 * dt + 4 * g) = w; }
}
__device__ __forceinline__ void na_phase(const bf16_t* __restrict__ QK, const bf16_t* __restrict__ Vt, bf16_t* __restrict__ O, const float* __restrict__ na_rpb, LAS unsigned char* lds, int G, int bx, int tid, int wave, int lane) {
    const int per = 2048 / G;
    u32x4 kreg[8], vreg[8]; bf16x8 qreg[2];
    int cur_h = -1;
    const int klr = tid >> 3, kc = tid & 7;
    const bool kok7 = (klr + 448) < NA_KEYS, vok = lane < 60;
    LAS unsigned char* kdst = lds + klr * 128 + ((kc ^ ((klr >> 1) & 7)) << 4);
    LAS unsigned char* vdst = lds + NA_V_OFF + wave * NA_ROWV + lane * 16;
#define NA_DECODE(it_, b_, h_, n_, rg_, kr0_, ks_) const int b_ = (it_) >> 8, h_ = ((it_) >> 4) & 15, n_ = ((it_) >> 2) & 3, rg_ = (it_) & 3; const int kr0_ = (rg_ == 0) ? 0 : (rg_ == 1) ? 4 : (rg_ == 2) ? 12 : 17, ks_ = min(max(16 * n_ - 8, 0), 32)
#define NA_LOAD(it_) do { NA_DECODE(it_, b_, h_, n_, rg_, kr0_, ks_); (void)rg_; \
        const bf16_t* ksrc = QK + ((size_t)b_ * 2048 + (kr0_ + (klr >> 5)) * 64 + ks_ + (klr & 31)) * 2048 + 1024 + h_ * 64 + 8 * kc;       \
        const bf16_t* vsrc = Vt + (size_t)(h_ * 64 + wave) * T + (size_t)b_ * 2048 + (kr0_ + (lane >> 2)) * 64 + ks_ + 8 * (lane & 3);     \
        _Pragma("unroll") for (int i = 0; i < 8; ++i) { if (i < 7 || kok7) kreg[i] = *(const u32x4*)(ksrc + (size_t)i * 128 * 2048); if (vok) vreg[i] = *(const u32x4*)(vsrc + (size_t)i * 8 * T); } \
        { const bf16_t* qp = QK + ((size_t)b_ * 2048 + (8 * rg_ + wave) * 64 + 16 * n_ + (lane & 15)) * 2048 + h_ * 64 + 8 * (lane >> 4); qreg[0] = *(const bf16x8*)qp; qreg[1] = *(const bf16x8*)(qp + 32); } } while (0)
    int it = bx * per;
    NA_LOAD(it);
#pragma unroll 1
    for (int ii = 0; ii < per; ++ii, ++it) {
        NA_DECODE(it, b, h, n, rg, kr0, ks); (void)ks;
        if (h != cur_h) { cur_h = h; LAS float* rp = (LAS float*)(lds + NA_BIAS_OFF);
            for (int i = tid; i < 960; i += 512) { const int dr = i >> 6, dc = (i & 63) - 16; rp[i] = (dc >= 0 && dc <= 30) ? na_rpb[(h * 15 + dr) * 31 + dc] : 0.f; } }
#pragma unroll
        for (int i = 0; i < 8; ++i) { if (i < 7 || kok7) *(LAS u32x4*)(kdst + i * 8192) = kreg[i]; if (vok) *(LAS u32x4*)(vdst + i * 8 * NA_ROWV) = vreg[i]; }
        const bf16x8 Q0 = qreg[0], Q1 = qreg[1];
        __syncthreads();
        if (ii + 1 < per) NA_LOAD(it + 1);
        na_unit(Q0, Q1, O, lds, b, 8 * rg + wave, h, n, kr0, lane);
        __syncthreads();
    }
#undef NA_LOAD
#undef NA_DECODE
}

constexpr int SW_KEYS = 384, SW_ROWV = 784, SW_V_OFF = SW_KEYS * 128, SW_TB_OFF = SW_V_OFF + 64 * SW_ROWV, SW_TBW = 320;
static_assert(SW_TB_OFF + 16 * SW_TBW * 4 <= RING_BYTES, "SWA LDS map");
template <bool EDGE>
__device__ __forceinline__ void swa_unit(const bf16x8 Q0, const bf16x8 Q1, bf16_t* __restrict__ O, const LAS unsigned char* lds, float sink, int b, int hq, int qb, int qt, int lane) {
    const int qi = lane & 15, g = lane >> 4, sw = (qi >> 1) & 7;
    const int q0 = 16 * qt, tq = b * 2048 + 128 * qb + q0, ts = qt < 6 ? qt : 6;
    const LAS unsigned char* kb0 = lds + (16 * ts + qi) * 128 + ((g ^ sw) << 4);
    const LAS unsigned char* kb1 = lds + (16 * ts + qi) * 128 + (((g + 4) ^ sw) << 4);
    const LAS unsigned char* vb = lds + SW_V_OFF + qi * SW_ROWV + (16 * ts + 4 * g) * 2;
    const LAS float* tbl = (const LAS float*)(lds + SW_TB_OFF) + hq * SW_TBW + (16 * ts + 4 * g - q0 - qi + 32);
    const int tok0 = 128 * (qb - 1) + 16 * ts + 4 * g;
    f32x4 S[18];
    att_qk<18, 3>(S, kb0, kb1, tbl, Q0, Q1, [](int t) { return 16 * t; }, [&](int t, const f32x4& c) { if (!EDGE) return c; f32x4 r;
#pragma unroll
        for (int q = 0; q < 4; ++q) r[q] = ((unsigned)(tok0 + 16 * t + q) < 2048u) ? c[q] : -1.0e30f;
        return r; });
    const float sum = att_softmax<18>(S, sink);
    f32x4 Oa[4];
#pragma unroll
    for (int dt = 0; dt < 4; ++dt) Oa[dt] = (f32x4){0.f, 0.f, 0.f, 0.f};
    att_pv<9, SW_ROWV, 18>(Oa, S, vb);
    const float inv = 1.0f / sum;
#pragma unroll
    for (int dt = 0; dt < 4; ++dt) { u32x2 w; w.x = cvt_pk_bf16(Oa[dt][0] * inv, Oa[dt][1] * inv); w.y = cvt_pk_bf16(Oa[dt][2] * inv, Oa[dt][3] * inv);
        *(u32x2*)(O + (size_t)(tq + qi) * D + hq * 64 + 16 * dt + 4 * g) = w; }
}
__device__ __forceinline__ int t5_bucket(int rel);
__device__ __forceinline__ void swa_phase(const bf16_t* __restrict__ QK, const bf16_t* __restrict__ Vt, bf16_t* __restrict__ O, const float* __restrict__ t5, const float* __restrict__ sinks, LAS unsigned char* lds, int G, int bx, int tid, int wave, int lane) {
    { LAS float* tb = (LAS float*)(lds + SW_TB_OFF);
      for (int i = tid; i < 16 * SW_TBW; i += 512) { const int hq = i / SW_TBW, rl = (i % SW_TBW) - 32; tb[i] = (rl >= 0 && rl <= 256) ? t5[t5_bucket(rl - 128) * 16 + hq] : -1.0e30f; } }
    const int klr = tid >> 3, kc = tid & 7;
    LAS unsigned char* kdst = lds + klr * 128 + ((kc ^ ((klr >> 1) & 7)) << 4);
    LAS unsigned char* vdst = lds + SW_V_OFF + wave * SW_ROWV + lane * 16;
    u32x4 kreg[6], vreg[8];
#define SW_LOAD(it_) do { const int b_ = (it_) >> 6, kvh_ = ((it_) >> 4) & 3, qb_ = (it_) & 15, s0_ = 128 * (qb_ - 1); \
        const bf16_t* kbase = QK + (size_t)b_ * 2048 * 1280 + 1024 + kvh_ * 64 + 8 * kc; \
        const bf16_t* vsrc = Vt + (size_t)(kvh_ * 64 + wave) * T + (size_t)b_ * 2048 + min(max(s0_ + 8 * lane, 0), 2040); \
        _Pragma("unroll") for (int i = 0; i < 6; ++i) { const int tk = min(max(s0_ + klr + 64 * i, 0), 2047); kreg[i] = *(const u32x4*)(kbase + (size_t)tk * 1280); } \
        if (lane < 48) { _Pragma("unroll") for (int i = 0; i < 8; ++i) vreg[i] = *(const u32x4*)(vsrc + (size_t)i * 8 * T); } } while (0)
#pragma unroll 1
    for (int it = bx; it < 512; it += G) {
        const int b = it >> 6, kvh = (it >> 4) & 3, qb = it & 15;
        SW_LOAD(it);
        bf16x8 q[4][2];
        { const bf16_t* qp = QK + ((size_t)b * 2048 + 128 * qb + 64 * (wave & 1) + (lane & 15)) * 1280 + (kvh * 4 + (wave >> 1)) * 64 + 8 * (lane >> 4);
#pragma unroll
          for (int u = 0; u < 4; ++u) { q[u][0] = *(const bf16x8*)(qp + (size_t)u * 16 * 1280); q[u][1] = *(const bf16x8*)(qp + (size_t)u * 16 * 1280 + 32); } }
#pragma unroll
        for (int i = 0; i < 6; ++i) *(LAS u32x4*)(kdst + i * 8192) = kreg[i];
        if (lane < 48) {
#pragma unroll
            for (int i = 0; i < 8; ++i) *(LAS u32x4*)(vdst + i * 8 * SW_ROWV) = vreg[i]; }
        __syncthreads();
        const int hq = kvh * 4 + (wave >> 1); const float sink = sinks[hq];
        const bool edge = (qb == 0 || qb == 15);
#pragma unroll 1
        for (int uu = 0; uu < 4; ++uu) {
            const bf16x8 qa = uu == 0 ? q[0][0] : uu == 1 ? q[1][0] : uu == 2 ? q[2][0] : q[3][0];
            const bf16x8 qb2 = uu == 0 ? q[0][1] : uu == 1 ? q[1][1] : uu == 2 ? q[2][1] : q[3][1];
            if (edge) swa_unit<true>(qa, qb2, O, lds, sink, b, hq, qb, (wave & 1) * 4 + uu, lane);
            else swa_unit<false>(qa, qb2, O, lds, sink, b, hq, qb, (wave & 1) * 4 + uu, lane);
        }
        __syncthreads();
    }
#undef SW_LOAD
}
__device__ __forceinline__ int t5_bucket(int rel) {
    const int n = rel < 0 ? -rel : rel; int lg;
    if (n < 8) lg = n; else { lg = 8 + (n >= 12) + (n >= 16) + (n >= 23) + (n >= 32) + (n >= 46) + (n >= 64) + (n >= 91); lg = lg < 15 ? lg : 15; }
    return (rel > 0 ? 16 : 0) + lg;
}

#ifndef SKIP
#define SKIP 0
#endif
#ifndef GEMM_ALIGN
#define GEMM_ALIGN true
#endif
#ifndef PROBE_REP
#define PROBE_REP 0
#endif
__device__ __forceinline__ int nrep(int bit) { int n = (PROBE_REP & bit) ? 2 : 1; asm volatile("" : "+s"(n)); return n; }
__global__ void __launch_bounds__(512, 2) fwd_kernel(Params p_unused) {
    extern __shared__ __attribute__((aligned(16))) unsigned char lds_raw[];
    LAS unsigned char* lds = (LAS unsigned char*)lds_raw;
    const int G = gridDim.x, bx = blockIdx.x;
    const int vcu = (G % 8 == 0) ? (bx % 8) * (G / 8) + bx / 8 : bx;
    const int NGW = G * 8;
#define PHASE_IDS const int tid = opaque((int)threadIdx.x), lane = tid & 63, wave = __builtin_amdgcn_readfirstlane(tid >> 6), gw = vcu * 8 + wave; (void)lane; (void)gw
#define GRID_BAR() do { xcd_barrier(bar); if (PROBE_REP & 4096) xcd_barrier(bar); } while (0)
    for (int u = threadIdx.x; u < (LDS_BYTES - LDSCTL_OFF) / 4; u += 512) ((LAS unsigned*)(lds + LDSCTL_OFF))[u] = 0u;
    __syncthreads();
    XcdBarrier bar;
    { KP* kp = kparams(); bar = xcd_barrier_post((unsigned*)(kp->ws + WS_CTL) + CW_BAR, (volatile LAS unsigned*)(lds + MISC_OFF) + 8); }

    if (!(SKIP & 1)) { KP* kp = kparams(); PHASE_IDS;
      for (int rep = nrep(2048); rep > 0; --rep) if (vcu < 96) p0_mod_item(kp->c, kp->ada_w, kp->ada_b, lds, vcu, tid, wave, lane, (float*)(kp->ws + WS_MOD));
      unsigned* q0 = (unsigned*)(kp->ws + WS_CTL) + 64;
      for (int rep = nrep(1); rep > 0; --rep) {
          const unsigned lim = (unsigned)CONV_P0 * (unsigned)(nrep(1) - rep + 1);
          for (;;) { unsigned it = 0u; if (lane == 0) it = __hip_atomic_fetch_add(q0, 1u, __ATOMIC_RELAXED, __HIP_MEMORY_SCOPE_AGENT);
              it = (unsigned)__builtin_amdgcn_readfirstlane(it); if (it >= lim) break; const int q = (int)(it % (unsigned)CONV_P0); conv_dispatch(kp, q < CONV_LATE0 ? q : q + CONV_LATE, lds + wave * CONV_TILE, lane); } } }
    GRID_BAR();

    for (int it = 0; it < ((PROBE_REP & 8192) ? 3 : 2); ++it) {
        const int l = (PROBE_REP & 8192) ? (it > 0 ? it - 1 : 0) : it;
        if (!(SKIP & 2)) { PHASE_IDS; for (int rep = (l == 0) ? nrep(1024) : 1; rep > 0; --rep) if (gw < T / 8) row_phase(kparams(), l == 0 ? 0 : 1, l, gw, lane); }
        GRID_BAR();
        if (!(SKIP & 4)) {
            KP* kp = kparams(); unsigned char* ws = kp->ws;
            const bf16_t* Wt = (const bf16_t*)(ws + (l == 0 ? WS_WQK0 : WS_WQK1));
            const int nqk = (l == 0) ? 2048 : 1280, nv = (l == 0) ? 1024 : 256;
            { pg8::StaticOrder S; S.init(T, nqk, D, G, bx); pg8::EpiBf16 E{(bf16_t*)(ws + WS_QK), nqk};
              for (int rep = nrep(32); rep > 0; --rep) pg8::gemm_phase<pg8::EpiBf16, pg8::StaticOrder>(lds, (const bf16_t*)(ws + WS_H), Wt, D, S, E); }
            { pg8::StaticOrder S; S.init(nv, T, D, G, (l == 0) ? bx : ((bx + 192) & 255)); pg8::EpiBf16 E{(bf16_t*)(ws + WS_VT), T};
              for (int rep = nrep(256); rep > 0; --rep) pg8::gemm_phase<pg8::EpiBf16, pg8::StaticOrder>(lds, Wt + (size_t)nqk * D, (const bf16_t*)(ws + WS_H), D, S, E); }
            if (l == 1 && bx >= 128) { PHASE_IDS; conv_dispatch(kp, CONV_LATE0 + (bx - 128) * 8 + wave, lds + wave * CONV_TILE, lane); }
        }
        GRID_BAR();
        if (SKIP & 8) {} else if (l == 0) {
            PHASE_IDS; KP* kp = kparams(); unsigned char* ws = kp->ws;
            if (!(SKIP & 1024)) for (int rep = nrep(2); rep > 0; --rep) na_phase((const bf16_t*)(ws + WS_QK), (const bf16_t*)(ws + WS_VT), (bf16_t*)(ws + WS_O), kp->na_rpb, lds, G, opaque_s(vcu), tid, wave, lane);
        } else {
            PHASE_IDS; KP* kp = kparams(); unsigned char* ws = kp->ws;
            if (!(SKIP & 2048)) for (int rep = nrep(4); rep > 0; --rep) swa_phase((const bf16_t*)(ws + WS_QK), (const bf16_t*)(ws + WS_VT), (bf16_t*)(ws + WS_O), kp->t5_bias, kp->sw_sinks, lds, G, opaque_s(vcu), tid, wave, lane);
        }
        GRID_BAR();
        if (!(SKIP & 16)) {
            KP* kp = kparams(); unsigned char* ws = kp->ws;
            pg8::StaticOrder S; S.init(T, D, D, G, bx);
            pg8::EpiRes E{(l == 0) ? kp->x : (const float*)(ws + WS_XA), (float*)(ws + WS_XA), (const float*)(ws + WS_MOD) + (size_t)(l * 8) * 6144 + 2 * D};
            for (int rep = (l == 0) ? nrep(512) : 1; rep > 0; --rep) pg8::gemm_phase<pg8::EpiRes, pg8::StaticOrder>(lds, (const bf16_t*)(ws + WS_O), (const bf16_t*)(ws + (l == 0 ? WS_WO0 : WS_WO1)), D, S, E);
        }
        GRID_BAR();
        if (!(SKIP & 32)) { PHASE_IDS; for (int rep = nrep(64); rep > 0; --rep) { router_phase(kparams(), l, lds, gw, tid, lane); __syncthreads(); } }
        GRID_BAR();
        if (!(SKIP & 128)) {
            PHASE_IDS; KP* kp = kparams(); unsigned char* ws = kp->ws;
            LAS unsigned* tab = (LAS unsigned*)(lds + TAB_OFF);
            pg8::GUSched S{G, bx, tab};
            for (int rep = nrep(128); rep > 0; --rep) { pg8::Unit u; if (S.next(wave, u)) topk_task(ws, u.pm, lane, tab + wave * 256, (u.pn & 15) == 0); }
            __syncthreads();
            pg8::EpiGLU E{ws + WS_ACT};
            for (int rep = nrep(8); rep > 0; --rep) pg8::gemm_phase<pg8::EpiGLU, pg8::GUSched, GEMM_ALIGN, true>(lds, (const bf16_t*)(ws + WS_H), (const bf16_t*)(ws + WS_WGU + (size_t)l * 16 * 4096 * 1024), D / 2, S, E);
        }
        GRID_BAR();
        if (!(SKIP & 256)) {
            KP* kp = kparams(); unsigned char* ws = kp->ws;
            pg8::DownSched S{G, bx};
            pg8::EpiDown E{(bf16_t*)(ws + WS_Y), (const float*)(ws + WS_GSEL)};
            for (int rep = nrep(16); rep > 0; --rep) pg8::gemm_phase<pg8::EpiDown, pg8::DownSched, GEMM_ALIGN, true>(lds, (const bf16_t*)(ws + WS_ACT), (const bf16_t*)(ws + WS_WD + (size_t)l * 16 * 1024 * 2048), FF / 2, S, E);
        }
        GRID_BAR();
    }
    if (!(SKIP & 512)) { PHASE_IDS; for (int rep = nrep(16384); rep > 0; --rep) if (gw < T / 8) row_phase(kparams(), 2, 1, gw, lane); }
}

extern "C" void kernel_launch(void* const* d_in, const int* in_sizes, int n_in, void* d_out, int out_size, void* d_ws, size_t ws_size, hipStream_t stream) {
    static int grid = 0;
    if (grid == 0) {
        if (n_in != 17 || out_size != T * D || ws_size < WS_END) { fprintf(stderr, "kernel_launch: unexpected shapes (n_in %d, out %d, ws %zu); nothing launched\n", n_in, out_size, ws_size); grid = -1; return; }
        int dev = 0, cus = 0, per_cu = 0;
        if (hipGetDevice(&dev) != hipSuccess || hipDeviceGetAttribute(&cus, hipDeviceAttributeMultiprocessorCount, dev) != hipSuccess) { grid = -1; return; }
        if (hipFuncSetAttribute((const void*)fwd_kernel, hipFuncAttributeMaxDynamicSharedMemorySize, LDS_BYTES) != hipSuccess) { fprintf(stderr, "kernel_launch: hipFuncSetAttribute failed\n"); grid = -1; return; }
        if (hipOccupancyMaxActiveBlocksPerMultiprocessor(&per_cu, (const void*)fwd_kernel, 512, LDS_BYTES) != hipSuccess || per_cu < 1)
            fprintf(stderr, "kernel_launch: note: occupancy query reports %d workgroups per CU\n", per_cu);
        (void)hipGetLastError();
        if (cus < 256) { fprintf(stderr, "kernel_launch: needs 256 CUs (one resident workgroup each), device has %d; nothing launched\n", cus); grid = -1; return; }
        grid = 256;
    }
    if (grid < 0) return;
    if (hipMemsetAsync((char*)d_ws + WS_CTL, 0, CTL_ZERO_BYTES, stream) != hipSuccess) return;
    Params p{};
    p.x = (const float*)d_in[0]; p.c = (const float*)d_in[1]; p.ada_w = (const float*)d_in[2]; p.ada_b = (const float*)d_in[3]; p.norm_g = (const float*)d_in[4];
    p.na_w_qkv = (const float*)d_in[5]; p.na_w_o = (const float*)d_in[6]; p.na_rpb = (const float*)d_in[7]; p.sw_w_qkv = (const float*)d_in[8]; p.sw_w_o = (const float*)d_in[9];
    p.sw_sinks = (const float*)d_in[10]; p.t5_bias = (const float*)d_in[11]; p.w_router = (const float*)d_in[12]; p.w_gate = (const float*)d_in[13]; p.w_up = (const float*)d_in[14];
    p.w_down = (const float*)d_in[15]; p.final_g = (const float*)d_in[16]; p.out = (float*)d_out; p.ws = (unsigned char*)d_ws;
    hipLaunchKernelGGL(fwd_kernel, dim3(grid), dim3(512), LDS_BYTES, stream, p);
}
```

```cpp
#include <hip/hip_runtime.h>
#include <cstdio>
#include <cstdint>

#define LAS __attribute__((address_space(3)))
#define GAS __attribute__((address_space(1)))
typedef unsigned short bf16_t;
typedef short bf16x8 __attribute__((ext_vector_type(8)));
typedef short bf16x4 __attribute__((ext_vector_type(4)));
typedef float f32x4 __attribute__((ext_vector_type(4)));
typedef float f32x2 __attribute__((ext_vector_type(2)));
typedef unsigned u32x4 __attribute__((ext_vector_type(4)));
typedef unsigned u32x2 __attribute__((ext_vector_type(2)));
typedef int v4i_t __attribute__((ext_vector_type(4)));

constexpr int BATCH = 8, SEQ = 2048, D = 1024, T = BATCH * SEQ;
constexpr int NE = 16, FF = 2048, CAP = 256, NBE = BATCH * NE;
constexpr float RMS_EPS = 1e-6f;
constexpr float LOG2E = 1.4426950408889634f;

constexpr size_t MiB = 1u << 20;
constexpr size_t WS_CTL = 0, CTL_ZERO_BYTES = 32768;
constexpr size_t WS_MOD = 2 * MiB;
constexpr size_t WS_WQK0 = 4 * MiB;
constexpr size_t WS_WO0 = 10 * MiB;
constexpr size_t WS_WQK1 = 12 * MiB;
constexpr size_t WS_WO1 = 16 * MiB;
constexpr size_t WS_AFF = 18 * MiB;
constexpr size_t WS_SLOT = 19 * MiB;
constexpr size_t WS_IDX = 20 * MiB;
constexpr size_t WS_GSEL = 20 * MiB + 256 * 1024;
constexpr size_t WS_WGU = 32 * MiB;
constexpr size_t WS_WD = 288 * MiB;
constexpr size_t WS_XA = 416 * MiB;
constexpr size_t WS_H = 480 * MiB;
constexpr size_t WS_BIG = 512 * MiB;
constexpr size_t WS_QK = WS_BIG, WS_VT = WS_BIG + 64 * MiB, WS_O = WS_BIG + 96 * MiB, WS_ACT = WS_BIG;
constexpr size_t WS_Y = 640 * MiB;
constexpr size_t WS_END = 704 * MiB;
constexpr int CW_BAR = 4096;

constexpr int RING_BYTES = 131072;
constexpr int TAB_OFF = RING_BYTES;
constexpr int LDSCTL_OFF = TAB_OFF + 8192, MISC_OFF = LDSCTL_OFF + 320;
constexpr int LDS_BYTES = 147456;
static_assert(MISC_OFF + 128 <= LDS_BYTES, "LDS map");

__device__ __forceinline__ unsigned cvt_pk_bf16(float lo, float hi) { unsigned r; asm volatile("v_cvt_pk_bf16_f32 %0, %1, %2" : "=v"(r) : "v"(lo), "v"(hi)); return r; }
__device__ __forceinline__ int opaque(int v) { asm volatile("" : "+v"(v)); return v; }
__device__ __forceinline__ int opaque_s(int v) { asm volatile("" : "+s"(v)); return v; }
__device__ __forceinline__ float bf_lo(unsigned w) { return __uint_as_float(w << 16); }
__device__ __forceinline__ float bf_hi(unsigned w) { return __uint_as_float(w & 0xffff0000u); }
__device__ __forceinline__ float wave_sum(float v) {
#pragma unroll
    for (int o = 1; o < 64; o <<= 1) v += __shfl_xor(v, o);
    return v;
}

namespace pg8 {
constexpr int BM = 256, BK = 64, HALF = 128, HTB = HALF * BK * 2, STAGE_BYTES = 8 * HTB, NXCD = 8, WGM = 8;
__host__ __device__ __forceinline__ int lds_byte(int r, int c) { const int st = (r >> 4) * 2 + (c >> 5), rr = r & 15, cc = c & 31, ob = rr * 64 + cc * 2; return st * 1024 + (ob ^ (((ob >> 9) & 1) << 5)); }
__host__ __device__ __forceinline__ void stage_rc(int b, int& R, int& C) { const int st = b / 1024, sb = b % 1024, swz = sb ^ (((sb >> 9) & 1) << 5); R = (st >> 1) * 16 + swz / 64; C = (st & 1) * 32 + (swz % 64) / 2; }
__host__ __device__ __forceinline__ int perm32(int rho) { const int n = rho >> 4, i = rho & 15; return 8 * (i >> 2) + 4 * n + (i & 3); }

struct Unit { int pm, pn; };

struct StaticOrder {
    int nM, nN, nwg, G, c, K;
    __device__ void init(int M, int N, int K_, int G_, int c_) { nM = M / BM; nN = N / BM; nwg = nM * nN; G = G_; c = c_; K = K_; }
    __device__ bool next(int i, Unit& u) const {
        const long L = (long)i * G + c; if (L >= nwg) return false;
        int wgid = (int)L; { const int q = nwg / NXCD, r = nwg % NXCD, xcd = wgid % NXCD, off = wgid / NXCD; wgid = (xcd < r ? xcd * (q + 1) : r * (q + 1) + (xcd - r) * q) + off; }
        const int nig = WGM * nN, gid = wgid / nig, fm = gid * WGM, gsz = (nM - fm) < WGM ? (nM - fm) : WGM;
        u.pm = fm + ((wgid % nig) % gsz); u.pn = (wgid % nig) / gsz; return true;
    }
    __device__ __forceinline__ unsigned row_off(int, const Unit& u, int rr) const { return (unsigned)((u.pm * BM + rr) * K) * 2u; }
};
struct GUSched {
    int G, c; const LAS unsigned* tab;
    __device__ bool next(int i, Unit& u) const {
        const int L = i * G + c; if (L >= 2048 || i >= 8) return false;
        const int round = L >> 8, w = L & 255, xcd = w & 7, j = w >> 3, nt = 2 * xcd + (j & 1), b = (j >> 1) & 7, e = 2 * round + (j >> 4);
        u.pm = b * 16 + e; u.pn = e * 16 + nt; return true;
    }
    __device__ __forceinline__ unsigned row_off(int ui, const Unit&, int rr) const { return tab[ui * 256 + rr]; }
};
struct DownSched {
    int G, c;
    __device__ bool next(int i, Unit& u) const {
        const int L = i * G + c; if (L >= 512) return false;
        const int round = L >> 8, w = L & 255, xcd = w & 7, j = w >> 3, e = 8 * round + xcd, b = j >> 2, nt = j & 3;
        u.pm = b * 16 + e; u.pn = e * 4 + nt; return true;
    }
    __device__ __forceinline__ unsigned row_off(int, const Unit& u, int rr) const { return (unsigned)((u.pm * BM + rr) * FF); }
};

struct EpiBf16 {
    static constexpr bool PERM = true;
    bf16_t* O; int ldc;
    __device__ __forceinline__ void operator()(const f32x4 (&acc)[2][2][4][2], const Unit& u, int wr, int wc, int fr, int fq) const {
        const int row0 = u.pm * BM + wr * 64 + fr; const int col0 = u.pn * BM + wc * 32 + 8 * fq;
#pragma unroll
        for (int ai = 0; ai < 2; ++ai)
#pragma unroll
            for (int m = 0; m < 4; ++m) { bf16_t* rowp = O + (size_t)(row0 + ai * HALF + m * 16) * ldc + col0;
#pragma unroll
                for (int bj = 0; bj < 2; ++bj) { const f32x4 v0 = acc[ai][bj][m][0], v1 = acc[ai][bj][m][1];
                    u32x4 w; w.x = cvt_pk_bf16(v0[0], v0[1]); w.y = cvt_pk_bf16(v0[2], v0[3]); w.z = cvt_pk_bf16(v1[0], v1[1]); w.w = cvt_pk_bf16(v1[2], v1[3]);
                    *(u32x4*)(rowp + bj * HALF) = w; } }
    }
};
struct EpiRes {
    static constexpr bool PERM = false;
    const float* base; float* out; const float* gate;
    __device__ __forceinline__ void operator()(const f32x4 (&acc)[2][2][4][2], const Unit& u, int wr, int wc, int fr, int fq) const {
        const int col0 = u.pn * BM + wc * 32 + 4 * fq; const int b = u.pm >> 3;
        f32x4 gv[2][2];
#pragma unroll
        for (int bj = 0; bj < 2; ++bj)
#pragma unroll
            for (int n = 0; n < 2; ++n) gv[bj][n] = *(const f32x4*)(gate + (size_t)b * 6144 + col0 + bj * HALF + n * 16);
#pragma unroll
        for (int ai = 0; ai < 2; ++ai)
#pragma unroll
            for (int m = 0; m < 4; ++m) { const size_t off = (size_t)(u.pm * BM + ai * HALF + wr * 64 + m * 16 + fr) * D + col0;
#pragma unroll
                for (int bj = 0; bj < 2; ++bj)
#pragma unroll
                    for (int n = 0; n < 2; ++n) { const f32x4 bs = *(const f32x4*)(base + off + bj * HALF + n * 16);
                        *(f32x4*)(out + off + bj * HALF + n * 16) = bs + gv[bj][n] * acc[ai][bj][m][n]; }
                if (m & 1) asm volatile("" ::: "memory"); }
    }
};
__device__ __forceinline__ float silu_mul(float g, float u) { return g * u * __builtin_amdgcn_rcpf(1.0f + __builtin_amdgcn_exp2f(-g * LOG2E)); }
__device__ __forceinline__ unsigned pk4_fp8(float a, float b, float c, float d) { unsigned w = 0u; w = __builtin_amdgcn_cvt_pk_fp8_f32(a, b, w, false); w = __builtin_amdgcn_cvt_pk_fp8_f32(c, d, w, true); return w; }
struct EpiGLU {
    static constexpr bool PERM = true;
    unsigned char* O;
    __device__ __forceinline__ void operator()(const f32x4 (&acc)[2][2][4][2], const Unit& u, int wr, int wc, int fr, int fq) const {
        const int row0 = u.pm * BM + wr * 64 + fr; const int col0 = (u.pn & 15) * HALF + wc * 32 + 8 * fq;
#pragma unroll
        for (int ai = 0; ai < 2; ++ai)
#pragma unroll
            for (int m = 0; m < 4; ++m) { unsigned char* rowp = O + (size_t)(row0 + ai * HALF + m * 16) * FF + col0;
                const f32x4 g0 = acc[ai][0][m][0] * 0.015625f, g1 = acc[ai][0][m][1] * 0.015625f, u0 = acc[ai][1][m][0] * 0.015625f, u1 = acc[ai][1][m][1] * 0.015625f;
                u32x2 w; w.x = pk4_fp8(silu_mul(g0[0], u0[0]), silu_mul(g0[1], u0[1]), silu_mul(g0[2], u0[2]), silu_mul(g0[3], u0[3]));
                w.y = pk4_fp8(silu_mul(g1[0], u1[0]), silu_mul(g1[1], u1[1]), silu_mul(g1[2], u1[2]), silu_mul(g1[3], u1[3]));
                *(u32x2*)rowp = w; }
    }
};
struct EpiDown {
    static constexpr bool PERM = true;
    bf16_t* O; const float* gsel;
    __device__ __forceinline__ void operator()(const f32x4 (&acc)[2][2][4][2], const Unit& u, int wr, int wc, int fr, int fq) const {
        const int row0 = u.pm * BM + wr * 64 + fr; const int col0 = (u.pn & 3) * BM + wc * 32 + 8 * fq;
#pragma unroll
        for (int ai = 0; ai < 2; ++ai)
#pragma unroll
            for (int m = 0; m < 4; ++m) { const int row = row0 + ai * HALF + m * 16; const float gs = gsel[row] * 0.015625f;     bf16_t* rowp = O + (size_t)row * D + col0;
#pragma unroll
                for (int bj = 0; bj < 2; ++bj) { const f32x4 v0 = acc[ai][bj][m][0] * gs, v1 = acc[ai][bj][m][1] * gs;
                    u32x4 w; w.x = cvt_pk_bf16(v0[0], v0[1]); w.y = cvt_pk_bf16(v0[2], v0[3]); w.z = cvt_pk_bf16(v1[0], v1[1]); w.w = cvt_pk_bf16(v1[2], v1[3]);
                    *(u32x4*)(rowp + bj * HALF) = w; } }
    }
};

template <class Epi, class Sched, bool ALIGN_EPI = true, bool FP8 = false>
__device__ __forceinline__ void gemm_phase(LAS unsigned char* lds, const bf16_t* A, const bf16_t* Bt, const int K, const Sched& S, const Epi& E) {
    const int tid = opaque((int)threadIdx.x), wid = __builtin_amdgcn_readfirstlane(tid >> 6), lane = tid & 63, wr = wid >> 2, wc = wid & 3, fr = lane & 15, fq = lane >> 4;
    const int nt = K / BK;
    unsigned voffB[2];
#pragma unroll
    for (int i = 0; i < 2; ++i) { int R, C; stage_rc(tid * 16 + i * 8192, R, C); const int Rb = Epi::PERM ? ((R & ~31) + perm32(R & 31)) : R; voffB[i] = (unsigned)(Rb * K + C) * 2u; }
    const size_t kstep = (size_t)(BK * 2);
    const size_t hstep = (size_t)HALF * K * 2;
    const size_t tstep = 2 * hstep;
    const unsigned ldsw = (unsigned)wid * 1024u;
    const int aoff = lds_byte(wr * 64 + fr, fq * 8), boff = lds_byte(wc * 32 + fr, fq * 8);
#define PG8_SA(b, h) (((b) * 2 + (h)) * HTB)
#define PG8_SB(b, h) ((4 + (b) * 2 + (h)) * HTB)
#define PG8_STAGE(bufoff, gbase, voff) do { _Pragma("unroll") for (int _i = 0; _i < 2; ++_i) \
        __builtin_amdgcn_global_load_lds((const unsigned*)((const char*)(gbase) + (voff)[_i]), (LAS unsigned*)(lds + (bufoff) + ldsw + _i * 8192), 16, 0, 0); } while (0)
#define PG8_LDA(dst, b, h) do { _Pragma("unroll") for (int m = 0; m < 4; ++m) _Pragma("unroll") for (int k = 0; k < 2; ++k) dst[m][k] = *(const LAS bf16x8*)(lds + PG8_SA(b, h) + aoff + m * 2048 + k * 1024); } while (0)
#define PG8_LDB(dst, b, h) do { _Pragma("unroll") for (int n = 0; n < 2; ++n) _Pragma("unroll") for (int k = 0; k < 2; ++k) dst[n][k] = *(const LAS bf16x8*)(lds + PG8_SB(b, h) + boff + n * 2048 + k * 1024); } while (0)
#define PG8_CAT(x, y) __builtin_shufflevector(__builtin_bit_cast(v4i_t, x), __builtin_bit_cast(v4i_t, y), 0, 1, 2, 3, 4, 5, 6, 7)
#define PG8_MMA(ai, bj, At, Bt_) do { __builtin_amdgcn_s_setprio(1); \
        if constexpr (FP8) { _Pragma("unroll") for (int m = 0; m < 4; ++m) _Pragma("unroll") for (int n = 0; n < 2; ++n) \
            asm volatile("v_mfma_scale_f32_16x16x128_f8f6f4 %0, %1, %2, %0, %3, %3 op_sel_hi:[0,0,0]" : "+v"(acc[ai][bj][m][n]) : "v"(PG8_CAT(Bt_[n][0], Bt_[n][1])), "v"(PG8_CAT(At[m][0], At[m][1])), "v"(one8)); } \
        else { _Pragma("unroll") for (int m = 0; m < 4; ++m) _Pragma("unroll") for (int n = 0; n < 2; ++n) _Pragma("unroll") for (int k = 0; k < 2; ++k) \
            acc[ai][bj][m][n] = __builtin_amdgcn_mfma_f32_16x16x32_bf16(Bt_[n][k], At[m][k], acc[ai][bj][m][n], 0, 0, 0); } \
        __builtin_amdgcn_s_setprio(0); } while (0)
#define PG8_WAIT_V(n) asm volatile("s_waitcnt vmcnt(" #n ")" ::: "memory")
#define PG8_WAIT_L(n) asm volatile("s_waitcnt lgkmcnt(" #n ")" ::: "memory")
#define PG8_BAR __builtin_amdgcn_s_barrier()
#define PG8_SCHED __builtin_amdgcn_sched_barrier(0)
#define PG8_OFFS(dst, ui_, u_) do { _Pragma("unroll") for (int _h = 0; _h < 2; ++_h) _Pragma("unroll") for (int _i = 0; _i < 2; ++_i) { int R_, C_; stage_rc(tid * 16 + _i * 8192, R_, C_); dst[_h][_i] = S.row_off(ui_, u_, _h * HALF + R_) + (unsigned)C_ * 2u; } } while (0)
    Unit cur, nxt; int ui = 0;
    if (!S.next(0, cur)) return;
    f32x4 acc[2][2][4][2];
#pragma unroll
    for (int a = 0; a < 2; ++a)
#pragma unroll
        for (int b = 0; b < 2; ++b)
#pragma unroll
            for (int m = 0; m < 4; ++m)
#pragma unroll
                for (int n = 0; n < 2; ++n) acc[a][b][m][n] = (f32x4){0.f, 0.f, 0.f, 0.f};
    bf16x8 At[4][2], B0[2][2], B1[2][2];
    int one8 = 0x7f7f7f7f; asm volatile("" : "+v"(one8));
    (void)one8;
    unsigned vA[2][2];
    PG8_OFFS(vA, 0, cur);
    const char* const A0 = (const char*)A;
    const char* cB = (const char*)Bt + (size_t)cur.pn * tstep;
    PG8_STAGE(PG8_SB(0, 0), cB, voffB); PG8_STAGE(PG8_SB(0, 1), cB + hstep, voffB); PG8_STAGE(PG8_SA(0, 0), A0, vA[0]); PG8_STAGE(PG8_SA(0, 1), A0, vA[1]);
    if (wr == 1) PG8_BAR;
    PG8_WAIT_V(2); PG8_BAR;
    PG8_STAGE(PG8_SB(1, 0), cB + kstep, voffB); PG8_STAGE(PG8_SA(1, 0), A0 + kstep, vA[0]); PG8_STAGE(PG8_SB(1, 1), cB + hstep + kstep, voffB);
    PG8_WAIT_V(6); PG8_BAR;
    for (;;) {
        const bool has_next = S.next(ui + 1, nxt);
        const char* nB = has_next ? (const char*)Bt + (size_t)nxt.pn * tstep : cB;
        for (int t = 0; t < nt; t += 2) {
            const bool last = (t == nt - 2);
            const char* a1 = A0 + (size_t)(t + 1) * kstep;
            const char* a2 = last ? A0 : A0 + (size_t)(t + 2) * kstep; const char* b2 = last ? nB : cB + (size_t)(t + 2) * kstep;
            const char* a3 = a2 + kstep; const char* b3 = b2 + kstep;
            unsigned wn[2][2];
            if (last && has_next) { PG8_OFFS(wn, ui + 1, nxt); }
            else {
#pragma unroll
                for (int h = 0; h < 2; ++h)
#pragma unroll
                    for (int i = 0; i < 2; ++i) wn[h][i] = vA[h][i]; }
            unsigned (&w0)[2] = wn[0]; unsigned (&w1)[2] = wn[1];
            PG8_LDB(B0, 0, 0); PG8_LDB(B1, 0, 1); PG8_SCHED; PG8_LDA(At, 0, 0); PG8_STAGE(PG8_SA(1, 1), a1, vA[1]);
            PG8_WAIT_V(8); PG8_WAIT_L(0); PG8_BAR; PG8_MMA(0, 0, At, B0); PG8_MMA(0, 1, At, B1); PG8_BAR; PG8_SCHED;
            PG8_LDA(At, 0, 1); PG8_STAGE(PG8_SB(0, 0), b2, voffB); PG8_STAGE(PG8_SB(0, 1), b2 + hstep, voffB); PG8_STAGE(PG8_SA(0, 0), a2, w0);
            PG8_WAIT_V(8); PG8_WAIT_L(0); PG8_BAR; PG8_MMA(1, 0, At, B0); PG8_MMA(1, 1, At, B1); PG8_BAR; PG8_SCHED;
            PG8_LDB(B0, 1, 0); PG8_LDB(B1, 1, 1); PG8_SCHED; PG8_LDA(At, 1, 0); PG8_STAGE(PG8_SA(0, 1), a2, w1);
            PG8_WAIT_V(8); PG8_WAIT_L(0); PG8_BAR; PG8_MMA(0, 0, At, B0); PG8_MMA(0, 1, At, B1); PG8_BAR; PG8_SCHED;
            PG8_LDA(At, 1, 1); PG8_STAGE(PG8_SB(1, 0), b3, voffB); PG8_STAGE(PG8_SB(1, 1), b3 + hstep, voffB); PG8_STAGE(PG8_SA(1, 0), a3, w0);
            PG8_WAIT_V(8); PG8_WAIT_L(0); PG8_BAR; PG8_MMA(1, 0, At, B0); PG8_MMA(1, 1, At, B1); PG8_BAR; PG8_SCHED;
        }
        if constexpr (FP8) asm volatile("s_nop 15\n\ts_nop 15" ::: "memory");
        if constexpr (ALIGN_EPI) { if (wr == 0) PG8_BAR; }
        E(acc, cur, wr, wc, fr, fq);
        if (!has_next) break;
#pragma unroll
        for (int a = 0; a < 2; ++a)
#pragma unroll
            for (int b = 0; b < 2; ++b)
#pragma unroll
                for (int m = 0; m < 4; ++m)
#pragma unroll
                    for (int n = 0; n < 2; ++n) acc[a][b][m][n] = (f32x4){0.f, 0.f, 0.f, 0.f};
        cur = nxt; cB = nB; ++ui;
        PG8_OFFS(vA, ui, cur);
        if constexpr (ALIGN_EPI) { if (wr == 1) PG8_BAR; }
    }
    PG8_WAIT_V(0);
    if constexpr (!ALIGN_EPI) { if (wr == 0) PG8_BAR; }
    PG8_BAR;
#undef PG8_SA
#undef PG8_SB
#undef PG8_STAGE
#undef PG8_LDA
#undef PG8_LDB
#undef PG8_MMA
#undef PG8_CAT
#undef PG8_WAIT_V
#undef PG8_WAIT_L
#undef PG8_BAR
#undef PG8_SCHED
#undef PG8_OFFS
}
}

#define XB_TMO      128
#define XB_XCNT(j)  (256  + 64 * (j))
#define XB_XSUB(j)  (1280 + 64 * (j))
#define XB_XGEN(j)  (2304 + 64 * (j))
#define XB_TOP      3328
#define XB_TOPGEN   3392
#define XCD_BAR_WORDS 3456
#define XB_SPIN_CAP (1u << 18)
__device__ __forceinline__ unsigned xb_ld(unsigned* p)              { return __hip_atomic_load(p, __ATOMIC_RELAXED, __HIP_MEMORY_SCOPE_AGENT); }
__device__ __forceinline__ unsigned xb_add(unsigned* p, unsigned v) { return __hip_atomic_fetch_add(p, v, __ATOMIC_RELAXED, __HIP_MEMORY_SCOPE_AGENT); }
__device__ __forceinline__ unsigned xb_xcc_id() { return (unsigned)__builtin_amdgcn_s_getreg((3 << 11) | 20) & 0xFu; }
#define XB_SPIN(cond, bar) do { unsigned _sp = 0; while (cond) { __builtin_amdgcn_s_sleep(1); \
    if ((++_sp & 255u) == 0u) { if (xb_ld(&(bar)[XB_TMO])) break; if (_sp > XB_SPIN_CAP) { atomicAdd(&(bar)[XB_TMO], 1u); break; } } } } while (0)
struct XcdBarrier { unsigned* bar; unsigned x; volatile LAS unsigned* st; };
__device__ __forceinline__ XcdBarrier xcd_barrier_post(unsigned* bar, volatile LAS unsigned* st) {
    XcdBarrier b; b.bar = bar; b.x = xb_xcc_id(); b.st = st;
    if (threadIdx.x == 0) (void)xb_add(&bar[XB_XCNT(b.x)], 1u);
    return b;
}
__device__ __forceinline__ void xcd_barrier_complete(unsigned* bar, unsigned x, unsigned& nloc, unsigned& nx) {
    const unsigned G = gridDim.x * gridDim.y * gridDim.z;
    unsigned sum, cnt, mine, sp = 0u;
    for (;;) {
        sum = 0u; cnt = 0u; mine = 0u;
#pragma unroll
        for (unsigned j = 0; j < 16; ++j) { const unsigned c = xb_ld(&bar[XB_XCNT(j)]); sum += c; cnt += (c > 0u) ? 1u : 0u; mine = (j == x) ? c : mine; }
        if (sum == G) break;
        __builtin_amdgcn_s_sleep(1);
        if ((++sp & 255u) == 0u) { if (xb_ld(&bar[XB_TMO])) break; if (sp > XB_SPIN_CAP) { atomicAdd(&bar[XB_TMO], 1u); break; } }
    }
    nloc = mine > 0u ? mine : 1u; nx = cnt > 0u ? cnt : 1u;
}
__device__ __forceinline__ void xcd_barrier(const XcdBarrier& b) {
    asm volatile("s_waitcnt vmcnt(0)" ::: "memory");
    __syncthreads();
    if (threadIdx.x == 0) {
        unsigned* bar = b.bar; unsigned bx_ = b.x; asm volatile("" : "+s"(bx_));
        __builtin_amdgcn_s_waitcnt(0);
        unsigned nloc = b.st[0], nx = b.st[1];
        if (nloc == 0u) { xcd_barrier_complete(bar, bx_, nloc, nx); b.st[0] = nloc; b.st[1] = nx; }
        const unsigned old = xb_add(&bar[XB_XSUB(bx_)], 1u);
        const unsigned gen = old / nloc;
        if (old + 1u == (gen + 1u) * nloc) {
            __builtin_amdgcn_fence(__ATOMIC_RELEASE, "agent");
            asm volatile("s_waitcnt vmcnt(0)" ::: "memory");
            const unsigned og = xb_add(&bar[XB_TOP], 1u);
            const unsigned tg = og / nx;
            if (og + 1u == (tg + 1u) * nx) xb_add(&bar[XB_TOPGEN], 1u);
            else XB_SPIN(xb_ld(&bar[XB_TOPGEN]) == tg, bar);
            __builtin_amdgcn_fence(__ATOMIC_ACQUIRE, "agent");
            xb_add(&bar[XB_XGEN(bx_)], 1u);
            asm volatile("s_waitcnt vmcnt(0)" ::: "memory");
        } else {
            XB_SPIN(xb_ld(&bar[XB_XGEN(bx_)]) == gen, bar);
            __builtin_amdgcn_fence(__ATOMIC_ACQUIRE, "agent");
            asm volatile("s_waitcnt vmcnt(0)" ::: "memory");
        }
    }
    __syncthreads();
}

struct Params {
    const float *x, *c, *ada_w, *ada_b, *norm_g, *na_w_qkv, *na_w_o, *na_rpb, *sw_w_qkv, *sw_w_o, *sw_sinks, *t5_bias, *w_router, *w_gate, *w_up, *w_down, *final_g;
    float* out; unsigned char* ws;
};

typedef const __attribute__((address_space(4))) Params KP;
__device__ __forceinline__ KP* kparams() { unsigned long long k = (unsigned long long)__builtin_amdgcn_kernarg_segment_ptr(); asm volatile("" : "+s"(k)); return (KP*)k; }

__device__ __forceinline__ void p0_mod_item(const float* __restrict__ cvec, const float* __restrict__ ada_w, const float* __restrict__ ada_b, LAS unsigned char* lds, int item, int tid, int wave, int lane, float* mod) {
    LAS float* sc = (LAS float*)lds;
    LAS float* red = (LAS float*)(lds + 32768);
    for (int i = tid; i < 8192; i += 512) { const int b = i >> 10, k = i & 1023; const float v = cvec[b * 1024 + k]; sc[k * 8 + b] = v / (1.f + expf(-v)); }
    __syncthreads();
    const int l = item / 48, nb = item % 48, n0 = nb * 128;
    const int colq = lane & 31, kpar = lane >> 5, s16 = wave * 2 + kpar;
    const float* wp = ada_w + ((size_t)l * 1024 + s16 * 64) * 6144 + n0 + 4 * colq;
    float acc[8][4];
#pragma unroll
    for (int b = 0; b < 8; ++b)
#pragma unroll
        for (int j = 0; j < 4; ++j) acc[b][j] = 0.f;
#pragma unroll 8
    for (int kk = 0; kk < 64; ++kk) {
        const f32x4 w4 = *(const f32x4*)(wp + (size_t)kk * 6144);
        const int k = s16 * 64 + kk;
        const f32x4 s0 = *(const LAS f32x4*)(sc + k * 8), s1 = *(const LAS f32x4*)(sc + k * 8 + 4);
#pragma unroll
        for (int b = 0; b < 4; ++b)
#pragma unroll
            for (int j = 0; j < 4; ++j) { acc[b][j] += s0[b] * w4[j]; acc[4 + b][j] += s1[b] * w4[j]; }
    }
#pragma unroll
    for (int b = 0; b < 8; ++b) *(LAS f32x4*)(red + ((s16 * 8 + b) * 128 + 4 * colq)) = (f32x4){acc[b][0], acc[b][1], acc[b][2], acc[b][3]};
    __syncthreads();
#pragma unroll
    for (int q = 0; q < 2; ++q) { const int o = tid + 512 * q, b = o >> 7, col = o & 127; float s = ada_b[l * 6144 + n0 + col];
#pragma unroll
        for (int k = 0; k < 16; ++k) s += red[(k * 8 + b) * 128 + col];
        mod[(size_t)(l * 8 + b) * 6144 + n0 + col] = s; }
    __syncthreads();
}
constexpr int CONV_ROW = 144, CONV_TILE = 64 * CONV_ROW;
__device__ __forceinline__ void conv_item(const float* __restrict__ src, int N, int K, int n0, int k0, bf16_t* __restrict__ dst, int mode, float scale, LAS unsigned char* tile, int lane) {
    const int n4 = lane & 15, kr = lane >> 4;
    const float* sp = src + (size_t)(k0 + 16 * kr) * N + n0 + 4 * n4;
    const int rn = lane >> 3, rc = lane & 7;
    size_t rowo[8];
#pragma unroll
    for (int ps = 0; ps < 8; ++ps) { const int nn = n0 + 8 * ps + rn; const int row = (mode == 0) ? nn : ((nn >> 7) * 256 + (nn & 127) + (mode == 2 ? 128 : 0)); rowo[ps] = (size_t)row * K + k0 + 8 * rc; }
#pragma unroll 1
    for (int step = 0; step < 4; ++step) {
        f32x4 v[16];
#pragma unroll
        for (int i = 0; i < 16; ++i) v[i] = __builtin_nontemporal_load((const f32x4*)(sp + (size_t)(step * 64 + i) * N));
#pragma unroll
        for (int j = 0; j < 4; ++j)
#pragma unroll
            for (int hf = 0; hf < 2; ++hf) { u32x4 w;
                w.x = cvt_pk_bf16(v[hf * 8 + 0][j] * scale, v[hf * 8 + 1][j] * scale); w.y = cvt_pk_bf16(v[hf * 8 + 2][j] * scale, v[hf * 8 + 3][j] * scale);
                w.z = cvt_pk_bf16(v[hf * 8 + 4][j] * scale, v[hf * 8 + 5][j] * scale); w.w = cvt_pk_bf16(v[hf * 8 + 6][j] * scale, v[hf * 8 + 7][j] * scale);
                *(LAS u32x4*)(tile + (4 * n4 + j) * CONV_ROW + kr * 32 + hf * 16) = w; }
#pragma unroll
        for (int ps = 0; ps < 8; ++ps) { const u32x4 w = *(const LAS u32x4*)(tile + (8 * ps + rn) * CONV_ROW + rc * 16);
            __builtin_nontemporal_store(w, (u32x4*)(dst + rowo[ps] + step * 64)); }
    }
}
__device__ __forceinline__ void conv_item8(const float* __restrict__ src, int N, int K, int n0, int k0, unsigned char* __restrict__ dst, int mode, LAS unsigned char* tile, int lane) {
    const int n4 = lane & 15, kr = lane >> 4;
    const float* sp = src + (size_t)(k0 + 16 * kr) * N + n0 + 4 * n4;
    const int rn = lane >> 3, rc = lane & 7;
#pragma unroll 1
    for (int pair = 0; pair < 2; ++pair) {
#pragma unroll
        for (int hs = 0; hs < 2; ++hs) {
            f32x4 v[16];
#pragma unroll
            for (int i = 0; i < 16; ++i) v[i] = __builtin_nontemporal_load((const f32x4*)(sp + (size_t)((pair * 2 + hs) * 64 + i) * N)) * 64.0f;
#pragma unroll
            for (int j = 0; j < 4; ++j) { u32x4 w;
                w.x = pg8::pk4_fp8(v[0][j], v[1][j], v[2][j], v[3][j]); w.y = pg8::pk4_fp8(v[4][j], v[5][j], v[6][j], v[7][j]);
                w.z = pg8::pk4_fp8(v[8][j], v[9][j], v[10][j], v[11][j]); w.w = pg8::pk4_fp8(v[12][j], v[13][j], v[14][j], v[15][j]);
                *(LAS u32x4*)(tile + (4 * n4 + j) * CONV_ROW + hs * 64 + kr * 16) = w; }
        }
#pragma unroll
        for (int ps = 0; ps < 8; ++ps) { const u32x4 w = *(const LAS u32x4*)(tile + (8 * ps + rn) * CONV_ROW + rc * 16);
            const int nn = n0 + 8 * ps + rn; const int row = (mode == 0) ? nn : ((nn >> 7) * 256 + (nn & 127) + (mode == 2 ? 128 : 0));
            __builtin_nontemporal_store(w, (u32x4*)(dst + (size_t)row * K + k0 + pair * 128 + 16 * rc)); }
    }
}
constexpr int CONV_ITEMS = 12704;
constexpr int CONV_LATE0 = 2048, CONV_LATE = 1024, CONV_P0 = CONV_ITEMS - CONV_LATE;
__device__ __forceinline__ void conv_dispatch(KP* kp, int it, LAS unsigned char* tile, int lane) {
    unsigned char* ws = kp->ws;
    if (it < 8192) {
        const int up = it >> 12, r0 = it & 4095, le = r0 >> 7, r = r0 & 127, kc = r >> 5, nb = r & 31;
        const float* src = (up ? kp->w_up : kp->w_gate) + (size_t)le * 1024 * 2048;
        conv_item8(src, 2048, 1024, nb * 64, kc * 256, ws + WS_WGU + (size_t)le * 4096 * 1024, up ? 2 : 1, tile, lane);
    } else if (it < 12288) {
        const int r0 = it - 8192, le = r0 >> 7, r = r0 & 127, kc = r >> 4, nb = r & 15;
        conv_item8(kp->w_down + (size_t)le * 2048 * 1024, 1024, 2048, nb * 64, kc * 256, ws + WS_WD + (size_t)le * 1024 * 2048, 0, tile, lane);
    } else if (it < 12480) { const int r = it - 12288, nb = r >> 2, kc = r & 3;
        conv_item(kp->na_w_qkv, 3072, 1024, nb * 64, kc * 256, (bf16_t*)(ws + WS_WQK0), 0, nb < 16 ? 0.125f : 1.f, tile, lane);
    } else if (it < 12544) { const int r = it - 12480, nb = r >> 2, kc = r & 3;
        conv_item(kp->na_w_o, 1024, 1024, nb * 64, kc * 256, (bf16_t*)(ws + WS_WO0), 0, 1.f, tile, lane);
    } else if (it < 12640) { const int r = it - 12544, nb = r >> 2, kc = r & 3;
        conv_item(kp->sw_w_qkv, 1536, 1024, nb * 64, kc * 256, (bf16_t*)(ws + WS_WQK1), 0, nb < 16 ? 0.125f : 1.f, tile, lane);
    } else { const int r = it - 12640, nb = r >> 2, kc = r & 3;
        conv_item(kp->sw_w_o, 1024, 1024, nb * 64, kc * 256, (bf16_t*)(ws + WS_WO1), 0, 1.f, tile, lane);
    }
}

__device__ __forceinline__ void row_phase(KP* kp, int mode, int l, int gw, int lane) {
    unsigned char* ws = kp->ws; const float* px = kp->x; const float* norm_g = kp->norm_g; const float* final_g = kp->final_g; float* outp = kp->out;
    const float* mod = (const float*)(ws + WS_MOD);
    float* XA = (float*)(ws + WS_XA); bf16_t* H = (bf16_t*)(ws + WS_H);
    const int* SLOT = (const int*)(ws + WS_SLOT); const bf16_t* Y = (const bf16_t*)(ws + WS_Y);
    const int row0 = gw * 8, b = row0 >> 11;
    const float* xin = (mode == 0) ? px : XA;
    f32x4 Av[4], Bv[4], G2[4];
#pragma unroll
    for (int j = 0; j < 4; ++j) { const int col = 4 * lane + 256 * j;
        if (mode < 2) { const f32x4 g = *(const f32x4*)(norm_g + (size_t)(l * 2 + 0) * D + col); const float* mb = mod + (size_t)(l * 8 + b) * 6144;
            const f32x4 sc = *(const f32x4*)(mb + D + col), sh = *(const f32x4*)(mb + col); Av[j] = g * (sc + 1.0f); Bv[j] = sh; }
        else { Av[j] = *(const f32x4*)(final_g + col); Bv[j] = (f32x4){0.f, 0.f, 0.f, 0.f}; }
        if (mode > 0) { const int lp = (mode == 1) ? (l - 1) : 1; G2[j] = *(const f32x4*)(mod + (size_t)(lp * 8 + b) * 6144 + 5 * D + col); }
        else G2[j] = (f32x4){0.f, 0.f, 0.f, 0.f}; }
    for (int r = 0; r < 8; ++r) {
        const int row = row0 + r;
        f32x4 v[4];
#pragma unroll
        for (int j = 0; j < 4; ++j) v[j] = *(const f32x4*)(xin + (size_t)row * D + 4 * lane + 256 * j);
        if (mode > 0) {
            const int sv = SLOT[(size_t)row * 16 + (lane & 15)];
            f32x4 a[4];
#pragma unroll
            for (int j = 0; j < 4; ++j) a[j] = (f32x4){0.f, 0.f, 0.f, 0.f};
#pragma unroll
            for (int e = 0; e < 16; ++e) { const int s = __builtin_amdgcn_readlane(sv, e);
                if (s >= 0) { const bf16_t* yr = Y + (size_t)((b * 16 + e) * 256 + s) * D + 4 * lane;
#pragma unroll
                    for (int j = 0; j < 4; ++j) { const u32x2 w = *(const u32x2*)(yr + 256 * j); a[j] += (f32x4){bf_lo(w.x), bf_hi(w.x), bf_lo(w.y), bf_hi(w.y)}; } } }
#pragma unroll
            for (int j = 0; j < 4; ++j) v[j] += G2[j] * a[j];
            if (mode == 1) {
#pragma unroll
                for (int j = 0; j < 4; ++j) *(f32x4*)(XA + (size_t)row * D + 4 * lane + 256 * j) = v[j]; }
        }
        float ss = 0.f;
#pragma unroll
        for (int j = 0; j < 4; ++j) ss += (v[j].x * v[j].x + v[j].y * v[j].y) + (v[j].z * v[j].z + v[j].w * v[j].w);
        const float rstd = 1.0f / sqrtf(wave_sum(ss) * (1.0f / D) + RMS_EPS);
        if (mode < 2) {
#pragma unroll
            for (int j = 0; j < 4; ++j) { const f32x4 o = v[j] * rstd * Av[j] + Bv[j]; u32x2 w; w.x = cvt_pk_bf16(o[0], o[1]); w.y = cvt_pk_bf16(o[2], o[3]);
                *(u32x2*)(H + (size_t)row * D + 4 * lane + 256 * j) = w; }
        } else {
#pragma unroll
            for (int j = 0; j < 4; ++j) *(f32x4*)(outp + (size_t)row * D + 4 * lane + 256 * j) = v[j] * rstd * Av[j];
        }
    }
}

__device__ __forceinline__ float reduce16(const float (&p)[16], int lane) {
    const bool b5 = lane & 32, b4 = lane & 16, b3 = lane & 8, b2 = lane & 4;
    float q[8], r[4], s[2];
#pragma unroll
    for (int i = 0; i < 8; ++i) { const float keep = b5 ? p[8 + i] : p[i], send = b5 ? p[i] : p[8 + i]; q[i] = keep + __shfl_xor(send, 32); }
#pragma unroll
    for (int i = 0; i < 4; ++i) { const float keep = b4 ? q[4 + i] : q[i], send = b4 ? q[i] : q[4 + i]; r[i] = keep + __shfl_xor(send, 16); }
#pragma unroll
    for (int i = 0; i < 2; ++i) { const float keep = b3 ? r[2 + i] : r[i], send = b3 ? r[i] : r[2 + i]; s[i] = keep + __shfl_xor(send, 8); }
    const float keep = b2 ? s[1] : s[0], send = b2 ? s[0] : s[1];
    float t = keep + __shfl_xor(send, 4);
    t += __shfl_xor(t, 2); t += __shfl_xor(t, 1);
    return t;
}
__device__ __forceinline__ void router_fill(const float* __restrict__ w_router, int l, LAS unsigned char* lds, int tid) {
    LAS float* wrT = (LAS float*)lds;
    for (int i = tid; i < 4096; i += 512) { const int k = i >> 2, e4 = i & 3; const f32x4 v = *(const f32x4*)(w_router + (size_t)l * 16384 + k * 16 + 4 * e4);
#pragma unroll
        for (int j = 0; j < 4; ++j) wrT[(4 * e4 + j) * 1024 + (k ^ (e4 << 3))] = v[j]; }
}
__device__ __forceinline__ void router_phase(KP* kp, int l, LAS unsigned char* lds, int gw, int tid, int lane) {
    unsigned char* ws = kp->ws; const float* w_router = kp->w_router; const float* norm_g = kp->norm_g;
    const float* mod = (const float*)(ws + WS_MOD);
    const float* XA = (const float*)(ws + WS_XA); unsigned char* H8 = ws + WS_H;
    float* AFF = (float*)(ws + WS_AFF); int* SLOT = (int*)(ws + WS_SLOT);
    LAS float* wrT = (LAS float*)lds;
    (void)w_router; (void)tid;
    const int row0 = gw * 8, b = row0 >> 11;
    f32x4 Av[4], Bv[4];
#pragma unroll
    for (int j = 0; j < 4; ++j) { const int col = 4 * lane + 256 * j; const f32x4 g = *(const f32x4*)(norm_g + (size_t)(l * 2 + 1) * D + col); const float* mb = mod + (size_t)(l * 8 + b) * 6144;
        const f32x4 sc = *(const f32x4*)(mb + 4 * D + col), sh = *(const f32x4*)(mb + 3 * D + col); Av[j] = g * (sc + 1.0f); Bv[j] = sh; }
    const int e_l = ((lane >> 5) & 1) * 8 + ((lane >> 4) & 1) * 4 + ((lane >> 3) & 1) * 2 + ((lane >> 2) & 1);
#pragma unroll 1
    for (int rq = 0; rq < 2; ++rq) {
        const int rb = row0 + 4 * rq;
        f32x4 ha[4][4];
#pragma unroll
        for (int r = 0; r < 4; ++r)
#pragma unroll
            for (int j = 0; j < 4; ++j) ha[r][j] = *(const f32x4*)(XA + (size_t)(rb + r) * D + 4 * lane + 256 * j);
        float sa[4];
#pragma unroll
        for (int r = 0; r < 4; ++r) { float t = 0.f;
#pragma unroll
            for (int j = 0; j < 4; ++j) t += (ha[r][j].x * ha[r][j].x + ha[r][j].y * ha[r][j].y) + (ha[r][j].z * ha[r][j].z + ha[r][j].w * ha[r][j].w);
            sa[r] = t; }
#pragma unroll
        for (int o = 1; o < 64; o <<= 1) {
#pragma unroll
            for (int r = 0; r < 4; ++r) sa[r] += __shfl_xor(sa[r], o); }
#pragma unroll
        for (int r = 0; r < 4; ++r) { const float rs = 1.0f / sqrtf(sa[r] * (1.0f / D) + RMS_EPS);
#pragma unroll
            for (int j = 0; j < 4; ++j) { ha[r][j] = ha[r][j] * rs * Av[j] + Bv[j];
                *(unsigned*)(H8 + (size_t)(rb + r) * D + 4 * lane + 256 * j) = pg8::pk4_fp8(ha[r][j][0], ha[r][j][1], ha[r][j][2], ha[r][j][3]); } }
        float pa[4][16];
#pragma unroll
        for (int e = 0; e < 16; ++e) { float x0 = 0.f, x1 = 0.f, x2 = 0.f, x3 = 0.f;
#pragma unroll
            for (int j = 0; j < 4; ++j) { const f32x4 w = *(const LAS f32x4*)(wrT + e * 1024 + ((4 * lane + 256 * j) ^ ((e >> 2) << 3)));
                x0 += (ha[0][j].x * w.x + ha[0][j].y * w.y) + (ha[0][j].z * w.z + ha[0][j].w * w.w); x1 += (ha[1][j].x * w.x + ha[1][j].y * w.y) + (ha[1][j].z * w.z + ha[1][j].w * w.w);
                x2 += (ha[2][j].x * w.x + ha[2][j].y * w.y) + (ha[2][j].z * w.z + ha[2][j].w * w.w); x3 += (ha[3][j].x * w.x + ha[3][j].y * w.y) + (ha[3][j].z * w.z + ha[3][j].w * w.w); }
            pa[0][e] = x0; pa[1][e] = x1; pa[2][e] = x2; pa[3][e] = x3; if ((e & 3) == 3) asm volatile("" ::: "memory"); }
        float lg[4], mx[4], ex[4], sm[4];
#pragma unroll
        for (int r = 0; r < 4; ++r) { lg[r] = reduce16(pa[r], lane); mx[r] = lg[r]; }
#pragma unroll
        for (int o = 4; o < 64; o <<= 1) {
#pragma unroll
            for (int r = 0; r < 4; ++r) mx[r] = fmaxf(mx[r], __shfl_xor(mx[r], o)); }
#pragma unroll
        for (int r = 0; r < 4; ++r) { ex[r] = __builtin_amdgcn_exp2f((lg[r] - mx[r]) * LOG2E); sm[r] = ex[r]; }
#pragma unroll
        for (int o = 4; o < 64; o <<= 1) {
#pragma unroll
            for (int r = 0; r < 4; ++r) sm[r] += __shfl_xor(sm[r], o); }
#pragma unroll
        for (int r = 0; r < 4; ++r) {
            if ((lane & 3) == 0) AFF[(size_t)(b * 16 + e_l) * 2048 + ((rb + r) & 2047)] = ex[r] / sm[r];
            if (lane < 16) SLOT[(size_t)(rb + r) * 16 + lane] = -1; }
    }
}
__device__ __forceinline__ int wave_isum(int v) {
    v += __builtin_amdgcn_update_dpp(0, v, 0xB1, 0xF, 0xF, true);
    v += __builtin_amdgcn_update_dpp(0, v, 0x4E, 0xF, 0xF, true);
    v += __builtin_amdgcn_update_dpp(0, v, 0x141, 0xF, 0xF, true);
    v += __builtin_amdgcn_update_dpp(0, v, 0x140, 0xF, 0xF, true);
    return __builtin_amdgcn_readlane(v, 0) + __builtin_amdgcn_readlane(v, 16) + __builtin_amdgcn_readlane(v, 32) + __builtin_amdgcn_readlane(v, 48);
}
__device__ __forceinline__ void topk_task(unsigned char* ws, int task, int lane, LAS unsigned* tab, bool pub) {
    const float* AFF = (const float*)(ws + WS_AFF); int* SLOT = (int*)(ws + WS_SLOT); float* GSEL = (float*)(ws + WS_GSEL);
    const int b = task >> 4, e = task & 15;
    unsigned u[32];
#pragma unroll
    for (int j = 0; j < 32; ++j) u[j] = __float_as_uint(AFF[(size_t)task * 2048 + 64 * j + lane]);
    unsigned Tv = 0u;
#pragma unroll 1
    for (int bit = 29; bit >= 0; --bit) {
        const unsigned cand = Tv | (1u << bit); int cnt = 0;
#pragma unroll
        for (int j = 0; j < 32; ++j) cnt += (u[j] >= cand) ? 1 : 0;
        const int c = wave_isum(cnt);
        if (c >= CAP) { Tv = cand; if (c == CAP) break; }
    }
    int cgt = 0;
#pragma unroll
    for (int j = 0; j < 32; ++j) cgt += (u[j] > Tv) ? 1 : 0;
    int quota = CAP - wave_isum(cgt), base = 0;
    const unsigned long long lt = (1ull << lane) - 1ull;
#pragma unroll
    for (int j = 0; j < 32; ++j) {
        const bool gt = u[j] > Tv, eq = u[j] == Tv;
        const unsigned long long em = __ballot(eq);
        const int erank = __popcll(em & lt);
        const bool sel = gt || (eq && erank < quota);
        const int ne = __popcll(em); quota -= (ne < quota ? ne : quota);
        const unsigned long long sm = __ballot(sel);
        const int slot = base + __popcll(sm & lt);
        if (sel) { const int tokrow = b * 2048 + 64 * j + lane;
            tab[slot] = (unsigned)tokrow * 1024u;
            if (pub) { GSEL[task * 256 + slot] = __uint_as_float(u[j]); SLOT[(size_t)tokrow * 16 + e] = slot; } }
        base += __popcll(sm);
    }
}

__device__ __forceinline__ bf16x8 pack8(const f32x4& a, const f32x4& b) {
    u32x4 w; w.x = cvt_pk_bf16(a[0], a[1]); w.y = cvt_pk_bf16(a[2], a[3]); w.z = cvt_pk_bf16(b[0], b[1]); w.w = cvt_pk_bf16(b[2], b[3]); return __builtin_bit_cast(bf16x8, w); }
__device__ __forceinline__ bf16x8 lds_k(const LAS unsigned char* Kl, int kl, int c) { return *(const LAS bf16x8*)(Kl + kl * 128 + ((c ^ ((kl >> 1) & 7)) << 4)); }
__device__ __forceinline__ bf16x8 lds_v(const LAS unsigned char* vp) { const bf16x4 a = *(const LAS bf16x4*)vp, b = *(const LAS bf16x4*)(vp + 32); return (bf16x8){a[0], a[1], a[2], a[3], b[0], b[1], b[2], b[3]}; }

#define ATT_SB() __builtin_amdgcn_sched_barrier(0)
template <int NT, int GS, class CO, class CA>
__device__ __forceinline__ void att_qk(f32x4 (&S)[NT], const LAS unsigned char* kb0, const LAS unsigned char* kb1, const LAS float* ctab, const bf16x8 Q0, const bf16x8 Q1, const CO& coff, const CA& cadd) {
    constexpr int NG = NT / GS;
    bf16x8 fa[2][GS], fb[2][GS]; f32x4 ci[2][GS];
#define ATT_LD(set, grp) do { _Pragma("unroll") for (int tt = 0; tt < GS; ++tt) { const int t = (grp) * GS + tt; \
        fa[set][tt] = *(const LAS bf16x8*)(kb0 + t * 2048); fb[set][tt] = *(const LAS bf16x8*)(kb1 + t * 2048); const LAS float* cp = ctab + coff(t); \
        ci[set][tt] = (f32x4){cp[0], cp[1], cp[2], cp[3]}; } } while (0)
    ATT_LD(0, 0);
#pragma unroll
    for (int grp = 0; grp < NG; ++grp) {
        const int cur = grp & 1;
        if (grp + 1 < NG) { if (cur == 0) ATT_LD(1, grp + 1); else ATT_LD(0, grp + 1); }
        ATT_SB();
#pragma unroll
        for (int tt = 0; tt < GS; ++tt) { const int t = grp * GS + tt; S[t] = __builtin_amdgcn_mfma_f32_16x16x32_bf16(fa[cur][tt], Q0, cadd(t, ci[cur][tt]), 0, 0, 0); }
#pragma unroll
        for (int tt = 0; tt < GS; ++tt) { const int t = grp * GS + tt; S[t] = __builtin_amdgcn_mfma_f32_16x16x32_bf16(fb[cur][tt], Q1, S[t], 0, 0, 0); }
        ATT_SB();
    }
#undef ATT_LD
}
template <int NT>
__device__ __forceinline__ float att_softmax(f32x4 (&S)[NT], float extra) {
    float m0 = extra, m1 = -3.0e38f;
#pragma unroll
    for (int t = 0; t < NT; ++t) { m0 = fmaxf(m0, fmaxf(S[t][0], S[t][1])); m1 = fmaxf(m1, fmaxf(S[t][2], S[t][3])); }
    float mx = fmaxf(m0, m1);
    mx = fmaxf(mx, __shfl_xor(mx, 16)); mx = fmaxf(mx, __shfl_xor(mx, 32));
    const float nm = -mx * LOG2E;
    float s0 = 0.f, s1 = 0.f;
#pragma unroll
    for (int t = 0; t < NT; ++t) {
        const float e0 = __builtin_amdgcn_exp2f(__builtin_fmaf(S[t][0], LOG2E, nm)), e1 = __builtin_amdgcn_exp2f(__builtin_fmaf(S[t][1], LOG2E, nm));
        const float e2 = __builtin_amdgcn_exp2f(__builtin_fmaf(S[t][2], LOG2E, nm)), e3 = __builtin_amdgcn_exp2f(__builtin_fmaf(S[t][3], LOG2E, nm));
        S[t] = (f32x4){e0, e1, e2, e3}; s0 += e0 + e1; s1 += e2 + e3; }
    float sum = s0 + s1;
    sum += __shfl_xor(sum, 16); sum += __shfl_xor(sum, 32);
    return sum + __builtin_amdgcn_exp2f(__builtin_fmaf(extra, LOG2E, nm));
}
template <int NG2, int ROWV, int NT>
__device__ __forceinline__ void att_pv(f32x4 (&Oa)[4], const f32x4 (&S)[NT], const LAS unsigned char* vb) {
    bf16x4 va[2][4], vc[2][4];
#define ATT_LV(set, gi) do { _Pragma("unroll") for (int dt = 0; dt < 4; ++dt) { const LAS unsigned char* vp = vb + (gi) * 64 + dt * 16 * ROWV; \
        va[set][dt] = *(const LAS bf16x4*)vp; vc[set][dt] = *(const LAS bf16x4*)(vp + 32); } } while (0)
    ATT_LV(0, 0);
#pragma unroll
    for (int gi = 0; gi < NG2; ++gi) {
        const int cur = gi & 1;
        if (gi + 1 < NG2) { if (cur == 0) ATT_LV(1, gi + 1); else ATT_LV(0, gi + 1); }
        const bf16x8 Pf = pack8(S[2 * gi], S[2 * gi + 1]);
        ATT_SB();
#pragma unroll
        for (int dt = 0; dt < 4; ++dt) { const bf16x4 x = va[cur][dt], y = vc[cur][dt];
            Oa[dt] = __builtin_amdgcn_mfma_f32_16x16x32_bf16((bf16x8){x[0], x[1], x[2], x[3], y[0], y[1], y[2], y[3]}, Pf, Oa[dt], 0, 0, 0); }
        ATT_SB();
    }
#undef ATT_LV
}

constexpr int NA_KEYS = 480, NA_ROWV = 976, NA_K_BYTES = NA_KEYS * 128, NA_V_OFF = NA_K_BYTES, NA_BIAS_OFF = NA_V_OFF + 64 * NA_ROWV;
static_assert(NA_BIAS_OFF + 15 * 64 * 4 <= RING_BYTES, "NA LDS map");
__device__ __forceinline__ void na_unit(const bf16x8 Q0, const bf16x8 Q1, bf16_t* __restrict__ O, const LAS unsigned char* lds, int b, int r, int h, int n, int kr0, int lane) {
    const int qi = lane & 15, g = lane >> 4, sw = (qi >> 1) & 7;
    const int tq = b * 2048 + r * 64 + 16 * n;
    const int rs = min(max(r - 4, 0), 24), kstart = min(max(16 * n - 8, 0), 32), ro = rs - kr0;
    const LAS unsigned char* kb0 = lds + (ro * 32 + qi) * 128 + ((g ^ sw) << 4);
    const LAS unsigned char* kb1 = lds + (ro * 32 + qi) * 128 + (((g + 4) ^ sw) << 4);
    const LAS unsigned char* vb = lds + NA_V_OFF + qi * NA_ROWV + (ro * 32 + 4 * g) * 2;
    const LAS float* rpbT = (const LAS float*)(lds + NA_BIAS_OFF) + (rs - r + 7) * 64 + (kstart + 4 * g - (16 * n + qi) + 31);
    const int qc = 16 * n + qi, cstart = min(max(qc - 8, 0), 48), kc0 = kstart + 4 * g - cstart;
    f32x4 madd[2];
#pragma unroll
    for (int c = 0; c < 2; ++c)
#pragma unroll
        for (int q = 0; q < 4; ++q) madd[c][q] = ((unsigned)(kc0 + 16 * c + q) < 16u) ? 0.f : -1.0e30f;
    f32x4 S[16];
    att_qk<16, 2>(S, kb0, kb1, rpbT, Q0, Q1, [](int t) { return (t >> 1) * 64 + (t & 1) * 16; }, [&](int t, const f32x4& c) { return c + madd[t & 1]; });
    const float sum = att_softmax<16>(S, -3.0e38f);
    f32x4 Oa[4];
#pragma unroll
    for (int dt = 0; dt < 4; ++dt) Oa[dt] = (f32x4){0.f, 0.f, 0.f, 0.f};
    att_pv<8, NA_ROWV, 16>(Oa, S, vb);
    const float inv = 1.0f / sum;
#pragma unroll
    for (int dt = 0; dt < 4; ++dt) { u32x2 w; w.x = cvt_pk_bf16(Oa[dt][0] * inv, Oa[dt][1] * inv); w.y = cvt_pk_bf16(Oa[dt][2] * inv, Oa[dt][3] * inv);
        *(u32x2*)(O + (size_t)(tq + qi) * D + h * 64 + 16 * dt + 4 * g) = w; }
}
__device__ __forceinline__ void na_phase(const bf16_t* __restrict__ QK, const bf16_t* __restrict__ Vt, bf16_t* __restrict__ O, const float* __restrict__ na_rpb, LAS unsigned char* lds, int G, int bx, int tid, int wave, int lane) {
    const int per = 2048 / G;
    u32x4 kreg[8], vreg[8]; bf16x8 qreg[2];
    int cur_h = -1;
    const int klr = tid >> 3, kc = tid & 7;
    const bool kok7 = (klr + 448) < NA_KEYS, vok = lane < 60;
    LAS unsigned char* kdst = lds + klr * 128 + ((kc ^ ((klr >> 1) & 7)) << 4);
    LAS unsigned char* vdst = lds + NA_V_OFF + wave * NA_ROWV + lane * 16;
#define NA_DECODE(it_, b_, h_, n_, rg_, kr0_, ks_) const int b_ = (it_) >> 8, h_ = ((it_) >> 4) & 15, n_ = ((it_) >> 2) & 3, rg_ = (it_) & 3; const int kr0_ = (rg_ == 0) ? 0 : (rg_ == 1) ? 4 : (rg_ == 2) ? 12 : 17, ks_ = min(max(16 * n_ - 8, 0), 32)
#define NA_LOAD(it_) do { NA_DECODE(it_, b_, h_, n_, rg_, kr0_, ks_); (void)rg_; \
        const bf16_t* ksrc = QK + ((size_t)b_ * 2048 + (kr0_ + (klr >> 5)) * 64 + ks_ + (klr & 31)) * 2048 + 1024 + h_ * 64 + 8 * kc;       \
        const bf16_t* vsrc = Vt + (size_t)(h_ * 64 + wave) * T + (size_t)b_ * 2048 + (kr0_ + (lane >> 2)) * 64 + ks_ + 8 * (lane & 3);     \
        _Pragma("unroll") for (int i = 0; i < 8; ++i) { if (i < 7 || kok7) kreg[i] = *(const u32x4*)(ksrc + (size_t)i * 128 * 2048); if (vok) vreg[i] = *(const u32x4*)(vsrc + (size_t)i * 8 * T); } \
        { const bf16_t* qp = QK + ((size_t)b_ * 2048 + (8 * rg_ + wave) * 64 + 16 * n_ + (lane & 15)) * 2048 + h_ * 64 + 8 * (lane >> 4); qreg[0] = *(const bf16x8*)qp; qreg[1] = *(const bf16x8*)(qp + 32); } } while (0)
    int it = bx * per;
    NA_LOAD(it);
#pragma unroll 1
    for (int ii = 0; ii < per; ++ii, ++it) {
        NA_DECODE(it, b, h, n, rg, kr0, ks); (void)ks;
        if (h != cur_h) { cur_h = h; LAS float* rp = (LAS float*)(lds + NA_BIAS_OFF);
            for (int i = tid; i < 960; i += 512) { const int dr = i >> 6, dc = (i & 63) - 16; rp[i] = (dc >= 0 && dc <= 30) ? na_rpb[(h * 15 + dr) * 31 + dc] : 0.f; } }
#pragma unroll
        for (int i = 0; i < 8; ++i) { if (i < 7 || kok7) *(LAS u32x4*)(kdst + i * 8192) = kreg[i]; if (vok) *(LAS u32x4*)(vdst + i * 8 * NA_ROWV) = vreg[i]; }
        const bf16x8 Q0 = qreg[0], Q1 = qreg[1];
        __syncthreads();
        if (ii + 1 < per) NA_LOAD(it + 1);
        na_unit(Q0, Q1, O, lds, b, 8 * rg + wave, h, n, kr0, lane);
        __syncthreads();
    }
#undef NA_LOAD
#undef NA_DECODE
}

constexpr int SW_KEYS = 384, SW_ROWV = 784, SW_V_OFF = SW_KEYS * 128, SW_TB_OFF = SW_V_OFF + 64 * SW_ROWV, SW_TBW = 320;
static_assert(SW_TB_OFF + 16 * SW_TBW * 4 <= RING_BYTES, "SWA LDS map");
template <bool EDGE>
__device__ __forceinline__ void swa_unit(const bf16x8 Q0, const bf16x8 Q1, bf16_t* __restrict__ O, const LAS unsigned char* lds, float sink, int b, int hq, int qb, int qt, int lane) {
    const int qi = lane & 15, g = lane >> 4, sw = (qi >> 1) & 7;
    const int q0 = 16 * qt, tq = b * 2048 + 128 * qb + q0, ts = qt < 6 ? qt : 6;
    const LAS unsigned char* kb0 = lds + (16 * ts + qi) * 128 + ((g ^ sw) << 4);
    const LAS unsigned char* kb1 = lds + (16 * ts + qi) * 128 + (((g + 4) ^ sw) << 4);
    const LAS unsigned char* vb = lds + SW_V_OFF + qi * SW_ROWV + (16 * ts + 4 * g) * 2;
    const LAS float* tbl = (const LAS float*)(lds + SW_TB_OFF) + hq * SW_TBW + (16 * ts + 4 * g - q0 - qi + 32);
    const int tok0 = 128 * (qb - 1) + 16 * ts + 4 * g;
    f32x4 S[18];
    att_qk<18, 3>(S, kb0, kb1, tbl, Q0, Q1, [](int t) { return 16 * t; }, [&](int t, const f32x4& c) { if (!EDGE) return c; f32x4 r;
#pragma unroll
        for (int q = 0; q < 4; ++q) r[q] = ((unsigned)(tok0 + 16 * t + q) < 2048u) ? c[q] : -1.0e30f;
        return r; });
    const float sum = att_softmax<18>(S, sink);
    f32x4 Oa[4];
#pragma unroll
    for (int dt = 0; dt < 4; ++dt) Oa[dt] = (f32x4){0.f, 0.f, 0.f, 0.f};
    att_pv<9, SW_ROWV, 18>(Oa, S, vb);
    const float inv = 1.0f / sum;
#pragma unroll
    for (int dt = 0; dt < 4; ++dt) { u32x2 w; w.x = cvt_pk_bf16(Oa[dt][0] * inv, Oa[dt][1] * inv); w.y = cvt_pk_bf16(Oa[dt][2] * inv, Oa[dt][3] * inv);
        *(u32x2*)(O + (size_t)(tq + qi) * D + hq * 64 + 16 * dt + 4 * g) = w; }
}
__device__ __forceinline__ int t5_bucket(int rel);
__device__ __forceinline__ void swa_phase(const bf16_t* __restrict__ QK, const bf16_t* __restrict__ Vt, bf16_t* __restrict__ O, const float* __restrict__ t5, const float* __restrict__ sinks, LAS unsigned char* lds, int G, int bx, int tid, int wave, int lane) {
    { LAS float* tb = (LAS float*)(lds + SW_TB_OFF);
      for (int i = tid; i < 16 * SW_TBW; i += 512) { const int hq = i / SW_TBW, rl = (i % SW_TBW) - 32; tb[i] = (rl >= 0 && rl <= 256) ? t5[t5_bucket(rl - 128) * 16 + hq] : -1.0e30f; } }
    const int klr = tid >> 3, kc = tid & 7;
    LAS unsigned char* kdst = lds + klr * 128 + ((kc ^ ((klr >> 1) & 7)) << 4);
    LAS unsigned char* vdst = lds + SW_V_OFF + wave * SW_ROWV + lane * 16;
    u32x4 kreg[6], vreg[8];
#define SW_LOAD(it_) do { const int b_ = (it_) >> 6, kvh_ = ((it_) >> 4) & 3, qb_ = (it_) & 15, s0_ = 128 * (qb_ - 1); \
        const bf16_t* kbase = QK + (size_t)b_ * 2048 * 1280 + 1024 + kvh_ * 64 + 8 * kc; \
        const bf16_t* vsrc = Vt + (size_t)(kvh_ * 64 + wave) * T + (size_t)b_ * 2048 + min(max(s0_ + 8 * lane, 0), 2040); \
        _Pragma("unroll") for (int i = 0; i < 6; ++i) { const int tk = min(max(s0_ + klr + 64 * i, 0), 2047); kreg[i] = *(const u32x4*)(kbase + (size_t)tk * 1280); } \
        if (lane < 48) { _Pragma("unroll") for (int i = 0; i < 8; ++i) vreg[i] = *(const u32x4*)(vsrc + (size_t)i * 8 * T); } } while (0)
#pragma unroll 1
    for (int it = bx; it < 512; it += G) {
        const int b = it >> 6, kvh = (it >> 4) & 3, qb = it & 15;
        SW_LOAD(it);
        bf16x8 q[4][2];
        { const bf16_t* qp = QK + ((size_t)b * 2048 + 128 * qb + 64 * (wave & 1) + (lane & 15)) * 1280 + (kvh * 4 + (wave >> 1)) * 64 + 8 * (lane >> 4);
#pragma unroll
          for (int u = 0; u < 4; ++u) { q[u][0] = *(const bf16x8*)(qp + (size_t)u * 16 * 1280); q[u][1] = *(const bf16x8*)(qp + (size_t)u * 16 * 1280 + 32); } }
#pragma unroll
        for (int i = 0; i < 6; ++i) *(LAS u32x4*)(kdst + i * 8192) = kreg[i];
        if (lane < 48) {
#pragma unroll
            for (int i = 0; i < 8; ++i) *(LAS u32x4*)(vdst + i * 8 * SW_ROWV) = vreg[i]; }
        __syncthreads();
        const int hq = kvh * 4 + (wave >> 1); const float sink = sinks[hq];
        const bool edge = (qb == 0 || qb == 15);
#pragma unroll 1
        for (int uu = 0; uu < 4; ++uu) {
            const bf16x8 qa = uu == 0 ? q[0][0] : uu == 1 ? q[1][0] : uu == 2 ? q[2][0] : q[3][0];
            const bf16x8 qb2 = uu == 0 ? q[0][1] : uu == 1 ? q[1][1] : uu == 2 ? q[2][1] : q[3][1];
            if (edge) swa_unit<true>(qa, qb2, O, lds, sink, b, hq, qb, (wave & 1) * 4 + uu, lane);
            else swa_unit<false>(qa, qb2, O, lds, sink, b, hq, qb, (wave & 1) * 4 + uu, lane);
        }
        __syncthreads();
    }
#undef SW_LOAD
}
__device__ __forceinline__ int t5_bucket(int rel) {
    const int n = rel < 0 ? -rel : rel; int lg;
    if (n < 8) lg = n; else { lg = 8 + (n >= 12) + (n >= 16) + (n >= 23) + (n >= 32) + (n >= 46) + (n >= 64) + (n >= 91); lg = lg < 15 ? lg : 15; }
    return (rel > 0 ? 16 : 0) + lg;
}

#ifndef SKIP
#define SKIP 0
#endif
#ifndef GEMM_ALIGN
#define GEMM_ALIGN true
#endif
#ifndef PROBE_REP
#define PROBE_REP 0
#endif
__device__ __forceinline__ int nrep(int bit) { int n = (PROBE_REP & bit) ? 2 : 1; asm volatile("" : "+s"(n)); return n; }
__global__ void __launch_bounds__(512, 2) fwd_kernel(Params p_unused) {
    extern __shared__ __attribute__((aligned(16))) unsigned char lds_raw[];
    LAS unsigned char* lds = (LAS unsigned char*)lds_raw;
    const int G = gridDim.x, bx = blockIdx.x;
    const int vcu = (G % 8 == 0) ? (bx % 8) * (G / 8) + bx / 8 : bx;
    const int NGW = G * 8;
#define PHASE_IDS const int tid = opaque((int)threadIdx.x), lane = tid & 63, wave = __builtin_amdgcn_readfirstlane(tid >> 6), gw = vcu * 8 + wave; (void)lane; (void)gw
#define GRID_BAR() do { xcd_barrier(bar); if (PROBE_REP & 4096) xcd_barrier(bar); } while (0)
    for (int u = threadIdx.x; u < (LDS_BYTES - LDSCTL_OFF) / 4; u += 512) ((LAS unsigned*)(lds + LDSCTL_OFF))[u] = 0u;
    __syncthreads();
    XcdBarrier bar;
    { KP* kp = kparams(); bar = xcd_barrier_post((unsigned*)(kp->ws + WS_CTL) + CW_BAR, (volatile LAS unsigned*)(lds + MISC_OFF) + 8); }

    if (!(SKIP & 1)) { KP* kp = kparams(); PHASE_IDS;
      for (int rep = nrep(2048); rep > 0; --rep) if (vcu < 96) p0_mod_item(kp->c, kp->ada_w, kp->ada_b, lds, vcu, tid, wave, lane, (float*)(kp->ws + WS_MOD));
      unsigned* q0 = (unsigned*)(kp->ws + WS_CTL) + 64;
      for (int rep = nrep(1); rep > 0; --rep) {
          const unsigned lim = (unsigned)CONV_P0 * (unsigned)(nrep(1) - rep + 1);
          for (;;) { unsigned it = 0u; if (lane == 0) it = __hip_atomic_fetch_add(q0, 1u, __ATOMIC_RELAXED, __HIP_MEMORY_SCOPE_AGENT);
              it = (unsigned)__builtin_amdgcn_readfirstlane(it); if (it >= lim) break; const int q = (int)(it % (unsigned)CONV_P0); conv_dispatch(kp, q < CONV_LATE0 ? q : q + CONV_LATE, lds + wave * CONV_TILE, lane); } } }
    GRID_BAR();

    for (int it = 0; it < ((PROBE_REP & 8192) ? 3 : 2); ++it) {
        const int l = (PROBE_REP & 8192) ? (it > 0 ? it - 1 : 0) : it;
        if (!(SKIP & 2)) { PHASE_IDS; for (int rep = (l == 0) ? nrep(1024) : 1; rep > 0; --rep) if (gw < T / 8) row_phase(kparams(), l == 0 ? 0 : 1, l, gw, lane); }
        GRID_BAR();
        if (!(SKIP & 4)) {
            KP* kp = kparams(); unsigned char* ws = kp->ws;
            const bf16_t* Wt = (const bf16_t*)(ws + (l == 0 ? WS_WQK0 : WS_WQK1));
            const int nqk = (l == 0) ? 2048 : 1280, nv = (l == 0) ? 1024 : 256;
            { pg8::StaticOrder S; S.init(T, nqk, D, G, bx); pg8::EpiBf16 E{(bf16_t*)(ws + WS_QK), nqk};
              for (int rep = nrep(32); rep > 0; --rep) pg8::gemm_phase<pg8::EpiBf16, pg8::StaticOrder>(lds, (const bf16_t*)(ws + WS_H), Wt, D, S, E); }
            { pg8::StaticOrder S; S.init(nv, T, D, G, (l == 0) ? bx : ((bx + 192) & 255)); pg8::EpiBf16 E{(bf16_t*)(ws + WS_VT), T};
              for (int rep = nrep(256); rep > 0; --rep) pg8::gemm_phase<pg8::EpiBf16, pg8::StaticOrder>(lds, Wt + (size_t)nqk * D, (const bf16_t*)(ws + WS_H), D, S, E); }
            if (l == 1 && bx >= 128) { PHASE_IDS; conv_dispatch(kp, CONV_LATE0 + (bx - 128) * 8 + wave, lds + wave * CONV_TILE, lane); }
        }
        GRID_BAR();
        if (SKIP & 8) {} else if (l == 0) {
            PHASE_IDS; KP* kp = kparams(); unsigned char* ws = kp->ws;
            if (!(SKIP & 1024)) for (int rep = nrep(2); rep > 0; --rep) na_phase((const bf16_t*)(ws + WS_QK), (const bf16_t*)(ws + WS_VT), (bf16_t*)(ws + WS_O), kp->na_rpb, lds, G, opaque_s(vcu), tid, wave, lane);
        } else {
            PHASE_IDS; KP* kp = kparams(); unsigned char* ws = kp->ws;
            if (!(SKIP & 2048)) for (int rep = nrep(4); rep > 0; --rep) swa_phase((const bf16_t*)(ws + WS_QK), (const bf16_t*)(ws + WS_VT), (bf16_t*)(ws + WS_O), kp->t5_bias, kp->sw_sinks, lds, G, opaque_s(vcu), tid, wave, lane);
        }
        GRID_BAR();
        if (!(SKIP & 16)) {
            KP* kp = kparams(); unsigned char* ws = kp->ws;
            pg8::StaticOrder S; S.init(T, D, D, G, bx);
            pg8::EpiRes E{(l == 0) ? kp->x : (const float*)(ws + WS_XA), (float*)(ws + WS_XA), (const float*)(ws + WS_MOD) + (size_t)(l * 8) * 6144 + 2 * D};
            for (int rep = (l == 0) ? nrep(512) : 1; rep > 0; --rep) pg8::gemm_phase<pg8::EpiRes, pg8::StaticOrder>(lds, (const bf16_t*)(ws + WS_O), (const bf16_t*)(ws + (l == 0 ? WS_WO0 : WS_WO1)), D, S, E);
            router_fill(kp->w_router, l, lds, opaque((int)threadIdx.x));
        }
        GRID_BAR();
        if (!(SKIP & 32)) { PHASE_IDS; for (int rep = nrep(64); rep > 0; --rep) { router_phase(kparams(), l, lds, gw, tid, lane); __syncthreads(); } }
        GRID_BAR();
        if (!(SKIP & 128)) {
            PHASE_IDS; KP* kp = kparams(); unsigned char* ws = kp->ws;
            LAS unsigned* tab = (LAS unsigned*)(lds + TAB_OFF);
            pg8::GUSched S{G, bx, tab};
            for (int rep = nrep(128); rep > 0; --rep) { pg8::Unit u; if (S.next(wave, u)) topk_task(ws, u.pm, lane, tab + wave * 256, (u.pn & 15) == 0); }
            __syncthreads();
            pg8::EpiGLU E{ws + WS_ACT};
            for (int rep = nrep(8); rep > 0; --rep) pg8::gemm_phase<pg8::EpiGLU, pg8::GUSched, GEMM_ALIGN, true>(lds, (const bf16_t*)(ws + WS_H), (const bf16_t*)(ws + WS_WGU + (size_t)l * 16 * 4096 * 1024), D / 2, S, E);
        }
        GRID_BAR();
        if (!(SKIP & 256)) {
            KP* kp = kparams(); unsigned char* ws = kp->ws;
            pg8::DownSched S{G, bx};
            pg8::EpiDown E{(bf16_t*)(ws + WS_Y), (const float*)(ws + WS_GSEL)};
            for (int rep = nrep(16); rep > 0; --rep) pg8::gemm_phase<pg8::EpiDown, pg8::DownSched, GEMM_ALIGN, true>(lds, (const bf16_t*)(ws + WS_ACT), (const bf16_t*)(ws + WS_WD + (size_t)l * 16 * 1024 * 2048), FF / 2, S, E);
        }
        GRID_BAR();
    }
    if (!(SKIP & 512)) { PHASE_IDS; for (int rep = nrep(16384); rep > 0; --rep) if (gw < T / 8) row_phase(kparams(), 2, 1, gw, lane); }
}

extern "C" void kernel_launch(void* const* d_in, const int* in_sizes, int n_in, void* d_out, int out_size, void* d_ws, size_t ws_size, hipStream_t stream) {
    static int grid = 0;
    if (grid == 0) {
        if (n_in != 17 || out_size != T * D || ws_size < WS_END) { fprintf(stderr, "kernel_launch: unexpected shapes (n_in %d, out %d, ws %zu); nothing launched\n", n_in, out_size, ws_size); grid = -1; return; }
        int dev = 0, cus = 0, per_cu = 0;
        if (hipGetDevice(&dev) != hipSuccess || hipDeviceGetAttribute(&cus, hipDeviceAttributeMultiprocessorCount, dev) != hipSuccess) { grid = -1; return; }
        if (hipFuncSetAttribute((const void*)fwd_kernel, hipFuncAttributeMaxDynamicSharedMemorySize, LDS_BYTES) != hipSuccess) { fprintf(stderr, "kernel_launch: hipFuncSetAttribute failed\n"); grid = -1; return; }
        if (hipOccupancyMaxActiveBlocksPerMultiprocessor(&per_cu, (const void*)fwd_kernel, 512, LDS_BYTES) != hipSuccess || per_cu < 1)
            fprintf(stderr, "kernel_launch: note: occupancy query reports %d workgroups per CU\n", per_cu);
        (void)hipGetLastError();
        if (cus < 256) { fprintf(stderr, "kernel_launch: needs 256 CUs (one resident workgroup each), device has %d; nothing launched\n", cus); grid = -1; return; }
        grid = 256;
    }
    if (grid < 0) return;
    if (hipMemsetAsync((char*)d_ws + WS_CTL, 0, CTL_ZERO_BYTES, stream) != hipSuccess) return;
    Params p{};
    p.x = (const float*)d_in[0]; p.c = (const float*)d_in[1]; p.ada_w = (const float*)d_in[2]; p.ada_b = (const float*)d_in[3]; p.norm_g = (const float*)d_in[4];
    p.na_w_qkv = (const float*)d_in[5]; p.na_w_o = (const float*)d_in[6]; p.na_rpb = (const float*)d_in[7]; p.sw_w_qkv = (const float*)d_in[8]; p.sw_w_o = (const float*)d_in[9];
    p.sw_sinks = (const float*)d_in[10]; p.t5_bias = (const float*)d_in[11]; p.w_router = (const float*)d_in[12]; p.w_gate = (const float*)d_in[13]; p.w_up = (const float*)d_in[14];
    p.w_down = (const float*)d_in[15]; p.final_g = (const float*)d_in[16]; p.out = (float*)d_out; p.ws = (unsigned char*)d_ws;
    hipLaunchKernelGGL(fwd_kernel, dim3(grid), dim3(512), LDS_BYTES, stream, p);
}
```
